# Optimizing an MI355X kernel written in HIP

```python
import jax, jax.numpy as jnp
from jax import lax
import numpy as np

D_MODEL = 1024
BATCH = 16
SEQ = 2048
DEPTH = 1
DEC_BATCH = 16
DEC_SEQ = 32
PAST_LEN = 1024

CHUNK = 64
N_META = 16
Q_BLOCK = 128
EPS = 1e-6
GLA_HEADS = 4
GLA_DK = 64
GLA_DV = 128
GLA_RANK = 16
GLA_TAU = 16.0
GLA_QK = GLA_HEADS * GLA_DK
GLA_V = GLA_HEADS * GLA_DV
FOX_HEADS = 8
FOX_DH = 64
FOX_W = FOX_HEADS * FOX_DH
FORGET_BIAS_INIT = 4.0
D_FF = 4 * D_MODEL
SPLIT_SIZES = (GLA_QK, GLA_QK, GLA_V, GLA_V, GLA_RANK, FOX_W, FOX_W, FOX_W, FOX_HEADS, D_MODEL, D_MODEL)
D_IN = GLA_QK + GLA_QK + GLA_V + GLA_V + GLA_RANK + FOX_W + FOX_W + FOX_W + FOX_HEADS + D_MODEL + D_MODEL
NEG = -1e30

kernel_name = 'hybrid_gla_fox_stream_step'


def _rmsnorm(x, g):
    xf = x.astype(jnp.float32)
    y = xf * lax.rsqrt(jnp.mean(xf * xf, axis=-1, keepdims=True) + EPS)
    return (y * g.astype(jnp.float32)).astype(x.dtype)


def _in_proj(hn, w_in):
    z = jnp.einsum('btd,de->bte', hn, w_in)
    cuts = [int(c) for c in np.cumsum(SPLIT_SIZES)[:-1]]
    return jnp.split(z, cuts, axis=-1)


def _gla_heads(gq, gk, gv, glr, w_gate, b_gate):
    B, T = gq.shape[0], gq.shape[1]
    f32 = jnp.float32
    q = gq.reshape(B, T, GLA_HEADS, GLA_DK).astype(f32) * (GLA_DK ** -0.5)
    k = gk.reshape(B, T, GLA_HEADS, GLA_DK).astype(f32)
    v = gv.reshape(B, T, GLA_HEADS, GLA_DV).astype(f32)
    z = jnp.einsum('btr,rk->btk', glr, w_gate) + b_gate
    log_a = (jax.nn.log_sigmoid(z.astype(f32)) / GLA_TAU).reshape(B, T, GLA_HEADS, GLA_DK)
    return q, k, v, log_a


def _gla_chunks(q, k, v, log_a, s0):
    g = jnp.cumsum(log_a, axis=2)
    g_tot = g[:, :, -1]
    k_dec = k * jnp.exp(g_tot[:, :, None] - g)
    u = jnp.einsum('bnchk,bnchv->bnhkv', k_dec, v)

    def step(s, inp):
        a, uc = inp
        s = jnp.exp(a)[..., None] * s + uc
        return s, s

    s_last, s_all = lax.scan(step, s0, (jnp.moveaxis(g_tot, 1, 0), jnp.moveaxis(u, 1, 0)))
    s_all = jnp.moveaxis(s_all, 0, 1)
    o = jnp.einsum('bnchk,bnhkv->bnchv', q, s_all)
    return o, s_last


def _gla_out(o, gr, g_norm, w_branch, dtype):
    B, T = o.shape[0], o.shape[1]
    on = _rmsnorm(o, g_norm)
    gate = jax.nn.silu(gr.astype(jnp.float32)).reshape(B, T, GLA_HEADS, GLA_DV)
    y = (on * gate).reshape(B, T, GLA_V).astype(dtype)
    return jnp.einsum('btv,vd->btd', y, w_branch)


def _fox_heads(fq, fk, fv, ff, b_f):
    B, T = fq.shape[0], fq.shape[1]
    sh = lambda a: a.reshape(B, T, FOX_HEADS, FOX_DH).transpose(0, 2, 1, 3)
    logf = jax.nn.log_sigmoid(ff.astype(jnp.float32) + b_f.astype(jnp.float32)).transpose(0, 2, 1)
    return sh(fq), sh(fk), sh(fv), logf


def _fox_attend(q, k, v, cq, ck, qpos, kpos):
    f32 = jnp.float32
    s = jnp.einsum('bhqd,bhkd->bhqk', q.astype(f32), k.astype(f32)) * (FOX_DH ** -0.5)
    s = s + cq[..., :, None] - ck[..., None, :]
    s = jnp.where(kpos[None, :] <= qpos[:, None], s, NEG)
    p = jax.nn.softmax(s, axis=-1)
    return jnp.einsum('bhqk,bhkd->bhqd', p, v.astype(f32))


def _fox_out(o, w_branch, dtype):
    B, T = o.shape[0], o.shape[2]
    y = o.transpose(0, 2, 1, 3).reshape(B, T, FOX_W).astype(dtype)
    return jnp.einsum('btf,fd->btd', y, w_branch)


def _merge_ffn(h, ya, yb, ga, gb, w_out, norm_ffn, w_up, w_down):
    m = jax.nn.sigmoid(ga) * ya + jax.nn.sigmoid(gb) * yb
    h = h + jnp.einsum('btd,de->bte', m, w_out)
    u = jnp.einsum('btd,df->btf', _rmsnorm(h, norm_ffn), w_up)
    return h + jnp.einsum('btf,fd->btd', jnp.square(jax.nn.relu(u)), w_down)


def _layer_prompt(h, norm_mix, w_in, w_gla_gate, b_gla_gate, g_gla_norm, b_fox_forget,
                  w_branch_gla, w_branch_fox, w_out, norm_ffn, w_up, w_down):
    B, L = h.shape[0], h.shape[1]
    n_real = L - N_META
    nc = n_real // CHUNK
    nb = n_real // Q_BLOCK
    hn = _rmsnorm(h, norm_mix)
    gq, gk, gv, gr, glr, fq, fk, fv, ff, ga, gb = _in_proj(hn, w_in)
    q, k, v, log_a = _gla_heads(gq, gk, gv, glr, w_gla_gate, b_gla_gate)
    lead = lambda a: a[:, None, :N_META]
    body = lambda a: a[:, N_META:].reshape((B, nc, CHUNK) + a.shape[2:])
    s0 = jnp.zeros((B, GLA_HEADS, GLA_DK, GLA_DV), jnp.float32)
    o_meta, s_meta = _gla_chunks(lead(q), lead(k), lead(v), lead(log_a), s0)
    o_body, s_last = _gla_chunks(body(q), body(k), body(v), body(log_a), s_meta)
    o = jnp.concatenate([o_meta.reshape(B, N_META, GLA_HEADS, GLA_DV),
                         o_body.reshape(B, n_real, GLA_HEADS, GLA_DV)], axis=1)
    ya = _gla_out(o, gr, g_gla_norm, w_branch_gla, h.dtype)
    fq_h, fk_h, fv_h, logf = _fox_heads(fq, fk, fv, ff, b_fox_forget)
    c = jnp.cumsum(logf, axis=-1)
    pos = jnp.arange(L)
    out_meta = _fox_attend(fq_h[:, :, :N_META], fk_h[:, :, :N_META], fv_h[:, :, :N_META],
                           c[..., :N_META], c[..., :N_META], pos[:N_META], pos[:N_META])
    qb = jnp.moveaxis(fq_h[:, :, N_META:].reshape(B, FOX_HEADS, nb, Q_BLOCK, FOX_DH), 2, 0)
    cb = jnp.moveaxis(c[..., N_META:].reshape(B, FOX_HEADS, nb, Q_BLOCK), 2, 0)
    pb = pos[N_META:].reshape(nb, Q_BLOCK)
    out_body = lax.map(lambda a: _fox_attend(a[0], fk_h, fv_h, a[1], c, a[2], pos), (qb, cb, pb))
    out_body = jnp.moveaxis(out_body, 0, 2).reshape(B, FOX_HEADS, n_real, FOX_DH)
    yb = _fox_out(jnp.concatenate([out_meta, out_body], axis=2), w_branch_fox, h.dtype)
    h = _merge_ffn(h, ya, yb, ga, gb, w_out, norm_ffn, w_up, w_down)
    return h, (fk_h, fv_h, logf, s_last)


def _layer_sample(h, cache_k, cache_v, cache_logf, state, norm_mix, w_in, w_gla_gate, b_gla_gate,
                  g_gla_norm, b_fox_forget, w_branch_gla, w_branch_fox, w_out, norm_ffn, w_up, w_down):
    B, T = h.shape[0], h.shape[1]
    past = cache_k.shape[2]
    hn = _rmsnorm(h, norm_mix)
    gq, gk, gv, gr, glr, fq, fk, fv, ff, ga, gb = _in_proj(hn, w_in)
    q, k, v, log_a = _gla_heads(gq, gk, gv, glr, w_gla_gate, b_gla_gate)
    o, s_new = _gla_chunks(q[:, None], k[:, None], v[:, None], log_a[:, None], state.astype(jnp.float32))
    ya = _gla_out(o.reshape(B, T, GLA_HEADS, GLA_DV), gr, g_gla_norm, w_branch_gla, h.dtype)
    fq_h, fk_h, fv_h, logf = _fox_heads(fq, fk, fv, ff, b_fox_forget)
    k_all = jnp.concatenate([cache_k.astype(fk_h.dtype), fk_h], axis=2)
    v_all = jnp.concatenate([cache_v.astype(fv_h.dtype), fv_h], axis=2)
    c_all = jnp.cumsum(jnp.concatenate([cache_logf.astype(jnp.float32), logf], axis=-1), axis=-1)
    kpos = jnp.arange(past + T)
    fo = _fox_attend(fq_h, k_all, v_all, c_all[..., past:], c_all, kpos[past:], kpos)
    yb = _fox_out(fo, w_branch_fox, h.dtype)
    h = _merge_ffn(h, ya, yb, ga, gb, w_out, norm_ffn, w_up, w_down)
    return h, (fk_h, fv_h, logf, s_new)


def setup_inputs(seed: int = 0) -> dict:
    key = jax.random.key(seed)
    ks = jax.random.split(key, 24)
    f32 = jnp.float32
    nrm = lambda k, shape, scale: jax.random.normal(k, shape, f32) * scale
    return {
        'x_prompt': nrm(ks[0], (BATCH, SEQ, D_MODEL), 1.0),
        'x_sample': nrm(ks[1], (DEC_BATCH, DEC_SEQ, D_MODEL), 1.0),
        'cache_fox_k': nrm(ks[2], (DEPTH, DEC_BATCH, FOX_HEADS, PAST_LEN, FOX_DH), 1.0),
        'cache_fox_v': nrm(ks[3], (DEPTH, DEC_BATCH, FOX_HEADS, PAST_LEN, FOX_DH), 1.0),
        'cache_fox_logf': jax.nn.log_sigmoid(FORGET_BIAS_INIT + nrm(ks[4], (DEPTH, DEC_BATCH, FOX_HEADS, PAST_LEN), 1.0)),
        'state_gla': nrm(ks[5], (DEPTH, DEC_BATCH, GLA_HEADS, GLA_DK, GLA_DV), 1.0),
        'meta_tokens': nrm(ks[6], (N_META, D_MODEL), 1.0),
        'norm_mix': 1.0 + nrm(ks[7], (DEPTH, D_MODEL), 0.05),
        'w_in': nrm(ks[8], (DEPTH, D_MODEL, D_IN), D_MODEL ** -0.5),
        'w_gla_gate': nrm(ks[9], (DEPTH, GLA_RANK, GLA_QK), GLA_RANK ** -0.5),
        'b_gla_gate': nrm(ks[10], (DEPTH, GLA_QK), 0.01),
        'g_gla_norm': 1.0 + nrm(ks[11], (DEPTH, GLA_DV), 0.05),
        'b_fox_forget': FORGET_BIAS_INIT + nrm(ks[12], (DEPTH, FOX_HEADS), 0.1),
        'w_branch_gla': nrm(ks[13], (DEPTH, GLA_V, D_MODEL), GLA_V ** -0.5),
        'w_branch_fox': nrm(ks[14], (DEPTH, FOX_W, D_MODEL), FOX_W ** -0.5),
        'w_out': nrm(ks[15], (DEPTH, D_MODEL, D_MODEL), D_MODEL ** -0.5),
        'norm_ffn': 1.0 + nrm(ks[16], (DEPTH, D_MODEL), 0.05),
        'w_up': nrm(ks[17], (DEPTH, D_MODEL, D_FF), D_MODEL ** -0.5),
        'w_down': nrm(ks[18], (DEPTH, D_FF, D_MODEL), D_FF ** -0.5),
        'norm_final': 1.0 + nrm(ks[19], (D_MODEL,), 0.05),
    }


def reference(x_prompt, x_sample, cache_fox_k, cache_fox_v, cache_fox_logf, state_gla,
              meta_tokens, norm_mix, w_in, w_gla_gate, b_gla_gate, g_gla_norm, b_fox_forget,
              w_branch_gla, w_branch_fox, w_out, norm_ffn, w_up, w_down, norm_final):
    B = x_prompt.shape[0]
    meta = jnp.broadcast_to(meta_tokens.astype(x_prompt.dtype)[None], (B, N_META, D_MODEL))
    h_p = jnp.concatenate([meta, x_prompt], axis=1)
    h_s = x_sample
    st_p, st_s = [], []
    for l in range(DEPTH):
        w = (norm_mix[l], w_in[l], w_gla_gate[l], b_gla_gate[l], g_gla_norm[l], b_fox_forget[l],
             w_branch_gla[l], w_branch_fox[l], w_out[l], norm_ffn[l], w_up[l], w_down[l])
        h_p, sp = _layer_prompt(h_p, *w)
        h_s, ss = _layer_sample(h_s, cache_fox_k[l], cache_fox_v[l], cache_fox_logf[l], state_gla[l], *w)
        st_p.append(sp)
        st_s.append(ss)
    y_prompt = _rmsnorm(h_p[:, N_META:], norm_final)
    y_sample = _rmsnorm(h_s, norm_final)
    new_fox_k_prompt = jnp.stack([s[0] for s in st_p])
    new_fox_v_prompt = jnp.stack([s[1] for s in st_p])
    new_fox_logf_prompt = jnp.stack([s[2] for s in st_p])
    new_gla_state_prompt = jnp.stack([s[3] for s in st_p])
    new_fox_k_sample = jnp.stack([s[0] for s in st_s])
    new_fox_v_sample = jnp.stack([s[1] for s in st_s])
    new_fox_logf_sample = jnp.stack([s[2] for s in st_s])
    new_gla_state_sample = jnp.stack([s[3] for s in st_s])
    return (y_prompt, y_sample, new_fox_k_prompt, new_fox_v_prompt, new_fox_logf_prompt, new_gla_state_prompt,
            new_fox_k_sample, new_fox_v_sample, new_fox_logf_sample, new_gla_state_sample)
```

```cpp
#include <hip/hip_runtime.h>
#include <hip/hip_cooperative_groups.h>
#include <cstdio>
#include <cstdint>
#include <cmath>
namespace cg = cooperative_groups;
namespace pg8 {
#define PG8_LAS __attribute__((address_space(3)))
typedef unsigned short bf16_t;
typedef short bf16x8 __attribute__((ext_vector_type(8)));
typedef float f32x4 __attribute__((ext_vector_type(4)));
typedef unsigned u32x4 __attribute__((ext_vector_type(4)));
constexpr int BM = 256, BK = 64, HALF = 128, HTB = HALF * BK * 2  , STAGE_BYTES = 8 * HTB, NXCD = 8, WGM = 8;

__host__ __device__ __forceinline__ int lds_byte(int r, int c) { const int st = (r >> 4) * 2 + (c >> 5), rr = r & 15, cc = c & 31, ob = rr * 64 + cc * 2; return st * 1024 + (ob ^ (((ob >> 9) & 1) << 5)); }
__host__ __device__ __forceinline__ void stage_rc(int b, int& R, int& C) { const int st = b / 1024, sb = b % 1024, swz = sb ^ (((sb >> 9) & 1) << 5); R = (st >> 1) * 16 + swz / 64; C = (st & 1) * 32 + (swz % 64) / 2; }
__host__ __device__ __forceinline__ int perm32(int rho) { const int n = rho >> 4, i = rho & 15; return 8 * (i >> 2) + 4 * n + (i & 3); }

struct Unit { int pm, pn, kofs, nt; };
struct Gemm { const bf16_t* A; const bf16_t* Bt; int M, N, K, ld; };

struct StaticOrder {
    int nM, nN, nwg, G, c;
    __host__ __device__ __forceinline__ void init(int M, int N, int G_, int c_) { nM = M / BM; nN = N / BM; nwg = nM * nN; G = G_; c = c_; }
    __host__ __device__ __forceinline__ bool next(int i, Unit& u) const {
        const long L = (long)i * G + c; if (L >= nwg) return false;
        int wgid = (int)L; { const int q = nwg / NXCD, r = nwg % NXCD, xcd = wgid % NXCD, off = wgid / NXCD; wgid = (xcd < r ? xcd * (q + 1) : r * (q + 1) + (xcd - r) * q) + off; }
        const int nig = WGM * nN, gid = wgid / nig, fm = gid * WGM, gsz = (nM - fm) < WGM ? (nM - fm) : WGM;
        u.pm = fm + ((wgid % nig) % gsz); u.pn = (wgid % nig) / gsz; u.kofs = 0; u.nt = 0; return true;
    }
    __device__ __forceinline__ void a_ready(const Unit&) const {}
    __device__ __forceinline__ void done(const Unit&) const {}
};

__device__ __forceinline__ unsigned cvt_pk_bf16(float lo, float hi) { unsigned r; asm volatile("v_cvt_pk_bf16_f32 %0, %1, %2" : "=v"(r) : "v"(lo), "v"(hi)); return r; }
typedef float f32x2 __attribute__((ext_vector_type(2)));
template <class Epi, class Sched, bool ALIGN_EPI = false, bool SP2 = false>
__device__ __forceinline__ void gemm_phase(PG8_LAS unsigned char* lds, const Gemm g, const Sched& S, const Epi& E) {
    int tid_ = threadIdx.x; asm volatile("" : "+v"(tid_));
    const int tid = tid_, wid = __builtin_amdgcn_readfirstlane(tid >> 6), lane = tid & 63, wr = wid >> 2, wc = wid & 3, fr = lane & 15, fq = lane >> 4;
    const int K = g.ld ? g.ld : g.K, nt = g.K / BK;
    unsigned voffA[2], voffB[2];
#pragma unroll
    for (int i = 0; i < 2; ++i) { int R, C; stage_rc(tid * 16 + i * 8192, R, C); const int Rb = Epi::PERM ? ((R & ~31) + perm32(R & 31)) : R;
        voffA[i] = (unsigned)(R * K + C) * 2u; voffB[i] = (unsigned)(Rb * K + C) * 2u; }
    const size_t kstep = (size_t)(BK * 2);
    const size_t hstep = (size_t)HALF * K * 2;
    const size_t tstep = 2 * hstep;
    const unsigned ldsw = (unsigned)wid * 1024u;
    const int aoff = lds_byte(wr * 64 + fr, fq * 8), boff = lds_byte(wc * 32 + fr, fq * 8);
#define PG8_SA(b, h) (((b) * 2 + (h)) * HTB)
#define PG8_SB(b, h) ((4 + (b) * 2 + (h)) * HTB)
#define PG8_STAGE(bufoff, gbase, voff) do { _Pragma("unroll") for (int _i = 0; _i < 2; ++_i) \
        __builtin_amdgcn_global_load_lds((const unsigned*)((const char*)(gbase) + (voff)[_i]), (PG8_LAS unsigned*)(lds + (bufoff) + ldsw + _i * 8192), 16, 0, 0); } while (0)
#define PG8_LDA(dst, b, h) do { _Pragma("unroll") for (int m = 0; m < 4; ++m) _Pragma("unroll") for (int k = 0; k < 2; ++k) dst[m][k] = *(const PG8_LAS bf16x8*)(lds + PG8_SA(b, h) + aoff + m * 2048 + k * 1024); } while (0)
#define PG8_LDB(dst, b, h) do { _Pragma("unroll") for (int n = 0; n < 2; ++n) _Pragma("unroll") for (int k = 0; k < 2; ++k) dst[n][k] = *(const PG8_LAS bf16x8*)(lds + PG8_SB(b, h) + boff + n * 2048 + k * 1024); } while (0)
#define PG8_MMA(ai, bj, At, Bt) do { __builtin_amdgcn_s_setprio(1); _Pragma("unroll") for (int m = 0; m < 4; ++m) _Pragma("unroll") for (int n = 0; n < 2; ++n) _Pragma("unroll") for (int k = 0; k < 2; ++k) \
        acc[ai][bj][m][n] = __builtin_amdgcn_mfma_f32_16x16x32_bf16(Bt[n][k], At[m][k], acc[ai][bj][m][n], 0, 0, 0); __builtin_amdgcn_s_setprio(0); } while (0)
#define PG8_WAIT_V(n) asm volatile("s_waitcnt vmcnt(" #n ")" ::: "memory")
#define PG8_WAIT_L(n) asm volatile("s_waitcnt lgkmcnt(" #n ")" ::: "memory")
#define PG8_BAR __builtin_amdgcn_s_barrier()
#define PG8_SCHED __builtin_amdgcn_sched_barrier(0)
    Unit cur, nxt; int ui = 0;
    if (!S.next(0, cur)) return;
    f32x4 acc[2][2][4][2];
#pragma unroll
    for (int a = 0; a < 2; ++a)
#pragma unroll
        for (int b = 0; b < 2; ++b)
#pragma unroll
            for (int m = 0; m < 4; ++m)
#pragma unroll
                for (int n = 0; n < 2; ++n) acc[a][b][m][n] = (f32x4){0.f, 0.f, 0.f, 0.f};
    bf16x8 At[4][2], B0[2][2], B1[2][2];
    const char* cA = (const char*)g.A + (size_t)cur.pm * tstep + cur.kofs; const char* cB = (const char*)g.Bt + (size_t)cur.pn * tstep + cur.kofs;
    S.a_ready(cur);
    if constexpr (SP2) {
        PG8_STAGE(PG8_SB(0, 0), cB, voffB); PG8_STAGE(PG8_SB(0, 1), cB + hstep, voffB); PG8_STAGE(PG8_SA(0, 0), cA, voffA); PG8_STAGE(PG8_SA(0, 1), cA + hstep, voffA);
        if (wr == 1) PG8_BAR;
        PG8_WAIT_V(2); PG8_BAR;
        PG8_STAGE(PG8_SB(1, 0), cB + kstep, voffB); PG8_STAGE(PG8_SA(1, 0), cA + kstep, voffA); PG8_STAGE(PG8_SB(1, 1), cB + hstep + kstep, voffB);
        PG8_WAIT_V(6); PG8_BAR;
    } else {
        PG8_STAGE(PG8_SB(0, 0), cB, voffB); PG8_STAGE(PG8_SA(0, 0), cA, voffA); PG8_STAGE(PG8_SB(0, 1), cB + hstep, voffB); PG8_STAGE(PG8_SA(0, 1), cA + hstep, voffA);
        if (wr == 1) PG8_BAR;
        PG8_WAIT_V(4); PG8_BAR;
        PG8_STAGE(PG8_SB(1, 0), cB + kstep, voffB); PG8_STAGE(PG8_SA(1, 0), cA + kstep, voffA); PG8_STAGE(PG8_SB(1, 1), cB + hstep + kstep, voffB);
        PG8_WAIT_V(6); PG8_BAR;
    }
    for (;;) {
        const bool has_next = S.next(ui + 1, nxt);
        const char* nA = has_next ? (const char*)g.A + (size_t)nxt.pm * tstep + nxt.kofs : cA; const char* nB = has_next ? (const char*)g.Bt + (size_t)nxt.pn * tstep + nxt.kofs : cB;
        const int nt_u = cur.nt > 0 ? cur.nt : nt;
        for (int t = 0; t < nt_u; t += 2) {
            const bool last = (t == nt_u - 2);
            const char* a1 = cA + (size_t)(t + 1) * kstep;
            const char* a2 = last ? nA : cA + (size_t)(t + 2) * kstep; const char* b2 = last ? nB : cB + (size_t)(t + 2) * kstep;
            const char* a3 = a2 + kstep; const char* b3 = b2 + kstep;
            if (last && has_next) S.a_ready(nxt);
            if constexpr (SP2) {
            PG8_LDB(B0, 0, 0); PG8_LDB(B1, 0, 1); PG8_SCHED; PG8_LDA(At, 0, 0); PG8_STAGE(PG8_SA(1, 1), a1 + hstep, voffA);
            PG8_WAIT_V(8); PG8_WAIT_L(0); PG8_BAR; PG8_MMA(0, 0, At, B0); PG8_MMA(0, 1, At, B1); PG8_BAR; PG8_SCHED;
            PG8_LDA(At, 0, 1); PG8_STAGE(PG8_SB(0, 0), b2, voffB); PG8_STAGE(PG8_SB(0, 1), b2 + hstep, voffB); PG8_STAGE(PG8_SA(0, 0), a2, voffA);
            PG8_WAIT_V(8); PG8_WAIT_L(0); PG8_BAR; PG8_MMA(1, 0, At, B0); PG8_MMA(1, 1, At, B1); PG8_BAR; PG8_SCHED;
            PG8_LDB(B0, 1, 0); PG8_LDB(B1, 1, 1); PG8_SCHED; PG8_LDA(At, 1, 0); PG8_STAGE(PG8_SA(0, 1), a2 + hstep, voffA);
            PG8_WAIT_V(8); PG8_WAIT_L(0); PG8_BAR; PG8_MMA(0, 0, At, B0); PG8_MMA(0, 1, At, B1); PG8_BAR; PG8_SCHED;
            PG8_LDA(At, 1, 1); PG8_STAGE(PG8_SB(1, 0), b3, voffB); PG8_STAGE(PG8_SB(1, 1), b3 + hstep, voffB); PG8_STAGE(PG8_SA(1, 0), a3, voffA);
            PG8_WAIT_V(8); PG8_WAIT_L(0); PG8_BAR; PG8_MMA(1, 0, At, B0); PG8_MMA(1, 1, At, B1); PG8_BAR; PG8_SCHED;
            } else {
            PG8_LDB(B0, 0, 0); PG8_SCHED; PG8_LDA(At, 0, 0); PG8_STAGE(PG8_SA(1, 1), a1 + hstep, voffA);
            PG8_WAIT_L(8); PG8_BAR; PG8_WAIT_L(0); PG8_MMA(0, 0, At, B0); PG8_BAR; PG8_SCHED;
            PG8_LDB(B1, 0, 1); PG8_STAGE(PG8_SB(0, 0), b2, voffB);
            PG8_BAR; PG8_WAIT_L(0); PG8_MMA(0, 1, At, B1); PG8_BAR;
            PG8_LDA(At, 0, 1); PG8_STAGE(PG8_SA(0, 0), a2, voffA);
            PG8_BAR; PG8_WAIT_L(0); PG8_MMA(1, 0, At, B0); PG8_BAR; PG8_SCHED;
            PG8_STAGE(PG8_SB(0, 1), b2 + hstep, voffB);
            PG8_WAIT_V(6); PG8_BAR; PG8_MMA(1, 1, At, B1); PG8_BAR;
            PG8_LDB(B0, 1, 0); PG8_SCHED; PG8_LDA(At, 1, 0); PG8_STAGE(PG8_SA(0, 1), a2 + hstep, voffA);
            PG8_WAIT_L(8); PG8_BAR; PG8_WAIT_L(0); PG8_MMA(0, 0, At, B0); PG8_BAR; PG8_SCHED;
            PG8_LDB(B1, 1, 1); PG8_STAGE(PG8_SB(1, 0), b3, voffB);
            PG8_BAR; PG8_WAIT_L(0); PG8_MMA(0, 1, At, B1); PG8_BAR;
            PG8_LDA(At, 1, 1); PG8_STAGE(PG8_SA(1, 0), a3, voffA);
            PG8_BAR; PG8_WAIT_L(0); PG8_MMA(1, 0, At, B0); PG8_BAR; PG8_SCHED;
            PG8_STAGE(PG8_SB(1, 1), b3 + hstep, voffB);
            PG8_WAIT_V(6); PG8_BAR; PG8_MMA(1, 1, At, B1); PG8_BAR;
            }
        }
        if constexpr (ALIGN_EPI) { if (wr == 0) PG8_BAR; }
        if constexpr (!Epi::AFTER_DRAIN) { E(acc, cur, wr, wc, fr, fq); S.done(cur); }
        if (!has_next) break;
#pragma unroll
        for (int a = 0; a < 2; ++a)
#pragma unroll
            for (int b = 0; b < 2; ++b)
#pragma unroll
                for (int m = 0; m < 4; ++m)
#pragma unroll
                    for (int n = 0; n < 2; ++n) acc[a][b][m][n] = (f32x4){0.f, 0.f, 0.f, 0.f};
        cur = nxt; cA = nA; cB = nB; ++ui;
        if constexpr (ALIGN_EPI) { if (wr == 1) PG8_BAR; }
    }
    PG8_WAIT_V(0);
    if constexpr (!ALIGN_EPI) { if (wr == 0) PG8_BAR; }
    PG8_BAR;
    if constexpr (Epi::AFTER_DRAIN) { E.fused(acc, cur, wr, wc, fr, fq, lds, wid, lane); S.done(cur); }
#undef PG8_SA
#undef PG8_SB
#undef PG8_STAGE
#undef PG8_LDA
#undef PG8_LDB
#undef PG8_MMA
#undef PG8_WAIT_V
#undef PG8_WAIT_L
#undef PG8_BAR
#undef PG8_SCHED
}
}

#ifndef PG8_SP2
#define PG8_SP2 true
#endif
#ifndef PG8_ALIGN
#define PG8_ALIGN true
#endif
#define LAS __attribute__((address_space(3)))
typedef unsigned short bf16;
typedef float f32x4 __attribute__((ext_vector_type(4)));
typedef float f32x16 __attribute__((ext_vector_type(16)));
typedef short bf16x8 __attribute__((ext_vector_type(8)));
typedef unsigned u32x4 __attribute__((ext_vector_type(4)));
typedef unsigned u32x2 __attribute__((ext_vector_type(2)));
using pg8::Unit;

constexpr int DM = 1024, NB = 16, LP = 2064, NMETA = 16, SEQ = 2048, DSQ = 32, PAST = 1024, LS = 1056;
constexpr int TOKP = NB * LP, TOKS = NB * DSQ, TOK = TOKP + TOKS;
constexpr int NIN = 5376, FF = 4096;
constexpr int ROWS = NB * SEQ + TOKS;
constexpr int VPP = 2112, VPS = 1088;
constexpr float EPS = 1e-6f, LOG2E = 1.4426950408889634f, C2 = 0.125f * 1.4426950408889634f;
constexpr int NTHREADS = 512;
constexpr int LDS_BYTES = 147456;

constexpr size_t MiB = 1u << 20;
constexpr size_t WS_CTL = 0;
constexpr size_t WS_SS2 = 1 * MiB;
constexpr size_t WS_GTOT = 3 * MiB + 512 * 1024;
constexpr size_t WS_CLP = 4 * MiB + 256 * 1024, WS_CLS = 5 * MiB + 512 * 1024;
constexpr size_t WS_WIN = 8 * MiB, WS_WBR = WS_WIN + 10 * MiB + 512 * 1024, WS_WOUT = WS_WBR + 2 * MiB, WS_WUP = WS_WOUT + 2 * MiB, WS_WDN = WS_WUP + 8 * MiB;
constexpr size_t D0 = 2 * MiB;
constexpr size_t WS_UF = D0 + 38 * MiB;
constexpr size_t WS_H2 = D0 + 300 * MiB;
constexpr size_t WS_H2B = D0 + 431 * MiB;
constexpr size_t WS_M = D0 + 38 * MiB, WS_MT = D0 + 103 * MiB + 512 * 1024;
constexpr size_t WS_YAB = D0 + 234 * MiB + 512 * 1024;
constexpr size_t WS_SB = D0 + 169 * MiB;
constexpr size_t WS_FQ = D0 + 300 * MiB, WS_FK = D0 + 332 * MiB + 512 * 1024, WS_FVT = D0 + 365 * MiB, WS_FKS = D0 + 398 * MiB, WS_FVTS = D0 + 415 * MiB;
constexpr size_t WS_U = D0 + 432 * MiB + 512 * 1024;
constexpr size_t WS_FQS = D0 + 501 * MiB;
constexpr size_t WS_PB = D0 + 433 * MiB;
constexpr size_t WS_GK = D0 + 38 * MiB, WS_GV = D0 + 54 * MiB + 512 * 1024, WS_HN = D0 + 88 * MiB;
constexpr size_t WS_END = D0 + 502 * MiB;
constexpr size_t DO_SA = 0, DO_GR = 66 * MiB, DO_GQ = 99 * MiB, DO_SM = 116 * MiB;
constexpr size_t O_YP = 0, O_YS = O_YP + (size_t)NB * SEQ * DM, O_KP = O_YS + (size_t)TOKS * DM, O_VP = O_KP + (size_t)128 * LP * 64, O_LFP = O_VP + (size_t)128 * LP * 64,
                 O_GSP = O_LFP + (size_t)128 * LP, O_KS = O_GSP + (size_t)64 * 8192, O_VS = O_KS + (size_t)128 * 32 * 64, O_LFS = O_VS + (size_t)128 * 32 * 64, O_GSS = O_LFS + 128 * 32,
                 O_END = O_GSS + (size_t)64 * 8192;

struct Params { const float* in[20]; float* out; unsigned char* ws; };

#define LDS_WAIT() asm volatile("s_waitcnt lgkmcnt(0)" ::: "memory")
__device__ __forceinline__ float bf2f(unsigned v) { return __uint_as_float(v << 16); }
__device__ __forceinline__ float bflo(unsigned w) { return __uint_as_float(w << 16); }
__device__ __forceinline__ float bfhi(unsigned w) { return __uint_as_float(w & 0xffff0000u); }
typedef float f32x2_t __attribute__((ext_vector_type(2))); typedef __bf16 bf16x2_t __attribute__((ext_vector_type(2)));
__device__ __forceinline__ unsigned pk2(float lo, float hi) { const f32x2_t v = {lo, hi}; const bf16x2_t b = __builtin_convertvector(v, bf16x2_t); return __builtin_bit_cast(unsigned, b); }
__device__ __forceinline__ unsigned short f2bf(float f) { return (unsigned short)(pk2(f, 0.f) & 0xffffu); }
__device__ __forceinline__ float wave_sum(float v) {
#pragma unroll
    for (int o = 1; o < 64; o <<= 1) v += __shfl_xor(v, o);
    return v;
}
__device__ __forceinline__ float logsig(float z) { return fminf(z, 0.f) - log1pf(expf(-fabsf(z))); }
__device__ __forceinline__ float logsig_fast(float z) { return fminf(z, 0.f) - __logf(1.f + __expf(-fabsf(z))); }
__device__ __forceinline__ float sigmoidf_(float x) { return __builtin_amdgcn_rcpf(1.f + __expf(-x)); }
__device__ __forceinline__ int permt(int t) { const int x = t & 15; return (t & ~15) | ((((x >> 2) & 1) << 3) + (x & 3) + ((x >> 3) << 2)); }
__device__ __forceinline__ int crow(int r, int hi) { return (r & 3) + 8 * (r >> 2) + 4 * hi; }
__device__ __forceinline__ void st8bf(bf16* p, f32x4 a, f32x4 b) { u32x4 w; w.x = pk2(a[0], a[1]); w.y = pk2(a[2], a[3]); w.z = pk2(b[0], b[1]); w.w = pk2(b[2], b[3]); *(u32x4*)p = w; }
__device__ __forceinline__ void ld8bf(const bf16* p, f32x4& a, f32x4& b) { const u32x4 w = *(const u32x4*)p; a = (f32x4){bflo(w.x), bfhi(w.x), bflo(w.y), bfhi(w.y)}; b = (f32x4){bflo(w.z), bfhi(w.z), bflo(w.w), bfhi(w.w)}; }

__device__ __forceinline__ const float* hrow(const Params& P, int r) {
    if (r < TOKP) { const int b = r / LP, t = r - b * LP; return t < NMETA ? P.in[6] + (size_t)t * DM : P.in[0] + ((size_t)b * SEQ + (t - NMETA)) * DM; }
    return P.in[1] + (size_t)(r - TOKP) * DM;
}

__device__ __forceinline__ int win_src(int n) {
    if (n < 1536) return n;
    if (n < 3072) return n + 16;
    if (n < 5120) return n + 24;
    const int i = n - 5120; if (i < 16) return 1536 + i; if (i < 24) return 3088 + (i - 16); return -1;
}
__device__ __forceinline__ void tr_item(const float* W, int ldw, int k0, int sc, const float* gk, bf16* WT, int ldk, LAS float* scr, int lane, bool permv) {
#pragma unroll 8
    for (int i = 0; i < 32; ++i) { const int kk = 2 * i + (lane >> 5); float v = sc >= 0 ? W[(size_t)(k0 + kk) * ldw + sc] : 0.f; if (gk) v *= gk[k0 + kk]; scr[kk * 33 + (lane & 31)] = v; }
    LDS_WAIT(); asm volatile("" ::: "memory");
    const int c = lane & 7;
#pragma unroll
    for (int j = 0; j < 4; ++j) { const int n = (lane >> 3) + 8 * j; const LAS float* s = scr + (8 * c) * 33 + n;
        u32x4 o; o.x = pk2(s[0 * 33], s[1 * 33]); o.y = pk2(s[2 * 33], s[3 * 33]); o.z = pk2(s[4 * 33], s[5 * 33]); o.w = pk2(s[6 * 33], s[7 * 33]);
        if (!permv) *(u32x4*)(WT + (size_t)n * ldk + k0 + 8 * c) = o;
        else { const int t0 = k0 + 8 * c, g16 = t0 & ~15, half = (t0 >> 3) & 1; bf16* d = WT + (size_t)n * ldk + g16 + 4 * half; *(u32x2*)d = (u32x2){o.x, o.y}; *(u32x2*)(d + 8) = (u32x2){o.z, o.w}; } }
    LDS_WAIT(); asm volatile("" ::: "memory");
}

__device__ __forceinline__ void tr_block(const float* W, int ldw, int k0, int nsrc0, const float* gk, bf16* WT, int ldk, LAS float* T) {
    const int tid = threadIdx.x;
    f32x4 v[8];
#pragma unroll
    for (int j = 0; j < 8; ++j) { const int idx = tid + 512 * j, row = idx >> 6, c4 = idx & 63;
        if (nsrc0 >= 0) v[j] = *(const f32x4*)(W + (size_t)(k0 + row) * ldw + nsrc0 + 4 * c4);
        else {
#pragma unroll
            for (int e = 0; e < 4; ++e) { const int sc = win_src(5120 + 4 * c4 + e); v[j][e] = sc >= 0 ? W[(size_t)(k0 + row) * ldw + sc] : 0.f; } } }
#pragma unroll
    for (int j = 0; j < 8; ++j) { const int idx = tid + 512 * j, row = idx >> 6, c4 = idx & 63; const float g = gk ? gk[k0 + row] : 1.f; LAS float* t = T + row * 257 + 4 * c4;
        t[0] = v[j][0] * g; t[1] = v[j][1] * g; t[2] = v[j][2] * g; t[3] = v[j][3] * g; }
    __syncthreads();
#pragma unroll
    for (int j = 0; j < 4; ++j) { const int idx = tid + 512 * j, n = idx >> 3, c = idx & 7; const LAS float* t = T + (8 * c) * 257 + n;
        u32x4 o; o.x = pk2(t[0], t[257]); o.y = pk2(t[2 * 257], t[3 * 257]); o.z = pk2(t[4 * 257], t[5 * 257]); o.w = pk2(t[6 * 257], t[7 * 257]);
        *(u32x4*)(WT + (size_t)n * ldk + k0 + 8 * c) = o; }
    __syncthreads();
}

__device__ __forceinline__ void p0_prologue(const Params& P, LAS unsigned char* L) {
    unsigned char* ws = P.ws;
    const int tid = threadIdx.x, lane = tid & 63, wave = __builtin_amdgcn_readfirstlane(tid >> 6);
    const int G = gridDim.x, gw = blockIdx.x * 8 + wave, NGW = G * 8;
    LAS float* scr = (LAS float*)(L + wave * 8448);
    bf16* Win = (bf16*)(ws + WS_WIN); bf16* Wbr = (bf16*)(ws + WS_WBR); bf16* Wout = (bf16*)(ws + WS_WOUT); bf16* Wup = (bf16*)(ws + WS_WUP); bf16* Wdn = (bf16*)(ws + WS_WDN);
    bf16* FVTs = (bf16*)(ws + WS_FVTS);
    {
        constexpr int B_IN = 16 * 21, B_BG = 8 * 4, B_BF = 8 * 4, B_OUT = 16 * 4, B_UP = 16 * 16, B_DN = 64 * 4;
        constexpr int NBLK = B_IN + B_BG + B_BF + B_OUT + B_UP + B_DN;
        LAS float* T = (LAS float*)L;
        for (int b = blockIdx.x; b < NBLK; b += G) {
            int r = b;
            if (r < B_IN) { const int kb = r / 21, nb = r % 21; const int n0 = 256 * nb; const int src = nb == 20 ? -1 : (n0 < 1536 ? n0 : (n0 < 3072 ? n0 + 16 : n0 + 24));
                tr_block(P.in[8], 5144, 64 * kb, src, P.in[7], Win + (size_t)n0 * 1024, 1024, T); continue; } r -= B_IN;
            if (r < B_BG) { const int kb = r / 4, nb = r % 4; tr_block(P.in[13], 1024, 64 * kb, 256 * nb, nullptr, Wbr + (size_t)(256 * nb) * 512, 512, T); continue; } r -= B_BG;
            if (r < B_BF) { const int kb = r / 4, nb = r % 4; tr_block(P.in[14], 1024, 64 * kb, 256 * nb, nullptr, Wbr + (size_t)(1024 + 256 * nb) * 512, 512, T); continue; } r -= B_BF;
            if (r < B_OUT) { const int kb = r / 4, nb = r % 4; tr_block(P.in[15], 1024, 64 * kb, 256 * nb, nullptr, Wout + (size_t)(256 * nb) * 1024, 1024, T); continue; } r -= B_OUT;
            if (r < B_UP) { const int kb = r / 16, nb = r % 16; tr_block(P.in[17], 4096, 64 * kb, 256 * nb, P.in[16], Wup + (size_t)(256 * nb) * 1024, 1024, T); continue; } r -= B_UP;
            { const int kb = r / 4, nb = r % 4; tr_block(P.in[18], 1024, 64 * kb, 256 * nb, nullptr, Wdn + (size_t)(256 * nb) * 4096, 4096, T); }
        }
    }
    constexpr int I_CV = 128 * 32;
    for (int it = gw; it < I_CV; it += NGW) {
        const int c = lane & 31, bh = it / 32, rem = it % 32, kb = rem >> 1, nb = rem & 1;
        tr_item(P.in[3] + (size_t)bh * PAST * 64, 64, 64 * kb, 32 * nb + c, nullptr, FVTs + ((size_t)bh * 64 + 32 * nb) * VPS, VPS, scr, lane, true);
    }
    bf16* HN = (bf16*)(ws + WS_HN);
    for (int r = gw; r < TOK; r += NGW) {
        const f32x4* xr = (const f32x4*)hrow(P, r) + lane; f32x4 v[4]; float s = 0.f;
#pragma unroll
        for (int j = 0; j < 4; ++j) { v[j] = xr[64 * j]; s += (v[j].x * v[j].x + v[j].y * v[j].y) + (v[j].z * v[j].z + v[j].w * v[j].w); }
        const float rstd = 1.0f / sqrtf(wave_sum(s) * (1.f / DM) + EPS);
        u32x2* o = (u32x2*)(HN + (size_t)r * DM) + lane;
#pragma unroll
        for (int j = 0; j < 4; ++j) o[64 * j] = (u32x2){pk2(v[j].x * rstd, v[j].y * rstd), pk2(v[j].z * rstd, v[j].w * rstd)};
    }
    bf16* FKs = (bf16*)(ws + WS_FKS); bf16* FK = (bf16*)(ws + WS_FK); bf16* FVT = (bf16*)(ws + WS_FVT);
    const int gt = blockIdx.x * NTHREADS + tid, NGT = G * NTHREADS;
    for (int ch = gt; ch < 128 * 8192; ch += NGT) { const int bh = ch >> 13, wi = ch & 8191; const f32x4* s = (const f32x4*)(P.in[2] + (size_t)ch * 8); st8bf(FKs + (size_t)bh * LS * 64 + wi * 8, s[0], s[1]); }
    if (gt < 64) ((unsigned*)(ws + WS_CTL))[gt] = 0u;
    for (int i = gt; i < 64 * 64 / 8; i += NGT) { *(u32x4*)(FK + (size_t)128 * LP * 64 + i * 8) = (u32x4){0, 0, 0, 0}; *(u32x4*)(FKs + (size_t)128 * LS * 64 + i * 8) = (u32x4){0, 0, 0, 0}; }
    for (int i = gt; i < 8192 * 6; i += NGT) { const int row = i / 6, c = i % 6; *(u32x4*)(FVT + (size_t)row * VPP + LP + c * 8) = (u32x4){0, 0, 0, 0}; }
    for (int i = gt; i < 8192 * 4; i += NGT) { const int row = i >> 2, c = i & 3; *(u32x4*)(FVTs + (size_t)row * VPS + LS + c * 8) = (u32x4){0, 0, 0, 0}; }
}

struct EpiIn {
    static constexpr bool PERM = true, AFTER_DRAIN = false;
    bf16 *GQ, *GK, *GV, *GR, *SA, *SB, *wsb; float *SM, *outb;
    template <int KIND> __device__ __forceinline__ void body(const f32x4 (&acc)[2][2][4][2], const Unit& u, int wr, int wc, int fr, int fq, int sub) const {
        const bool samp = u.pm >= 129; const int cw = wc * 32 + 8 * fq;
#pragma unroll
        for (int ai = 0; ai < 2; ++ai)
#pragma unroll
            for (int m = 0; m < 4; ++m) {
                const int r = u.pm * 256 + ai * 128 + wr * 64 + m * 16 + fr;
                int b, t; if (!samp) { b = r / LP; t = r - b * LP; } else { const int rs = r - TOKP; b = rs >> 5; t = rs & 31; }
#pragma unroll
                for (int bj = 0; bj < 2; ++bj) {
                    const int c8 = bj * 128 + cw; f32x4 v0 = acc[ai][bj][m][0], v1 = acc[ai][bj][m][1];
                    if (KIND == 0) st8bf(GQ + (size_t)r * 256 + c8, v0 * 0.125f, v1 * 0.125f);
                    else if (KIND == 1) st8bf(GK + (size_t)r * 256 + c8, v0, v1);
                    else if (KIND == 2) st8bf(GV + (size_t)r * 512 + sub * 256 + c8, v0, v1);
                    else if (KIND == 3) {
#pragma unroll
                        for (int i = 0; i < 4; ++i) { v0[i] = v0[i] * sigmoidf_(v0[i]); v1[i] = v1[i] * sigmoidf_(v1[i]); }
                        st8bf(GR + (size_t)r * 512 + sub * 256 + c8, v0, v1);
                    } else if (KIND == 4) {
                        const int h = sub * 4 + (c8 >> 6), d = c8 & 63;
                        const size_t eo = samp ? WS_FQS / 2 + ((size_t)(b * 8 + h) * 32 + t) * 64 + d : WS_FQ / 2 + ((size_t)(b * 8 + h) * LP + t) * 64 + d;
                        st8bf(wsb + eo, v0 * C2, v1 * C2);
                    } else if (KIND == 5) {
                        const int h = sub * 4 + (c8 >> 6), d = c8 & 63;
                        const size_t eo = samp ? WS_FKS / 2 + ((size_t)(b * 8 + h) * LS + PAST + t) * 64 + d : WS_FK / 2 + ((size_t)(b * 8 + h) * LP + t) * 64 + d;
                        const size_t oo = samp ? O_KS + ((size_t)(b * 8 + h) * 32 + t) * 64 + d : O_KP + ((size_t)(b * 8 + h) * LP + t) * 64 + d;
                        float* o = outb + oo;
                        st8bf(wsb + eo, v0, v1); *(f32x4*)o = v0; *(f32x4*)(o + 4) = v1;
                    } else if (KIND == 6) {
                        const int h = sub * 4 + (c8 >> 6), d = c8 & 63;
                        const size_t oo = samp ? O_VS + ((size_t)(b * 8 + h) * 32 + t) * 64 + d : O_VP + ((size_t)(b * 8 + h) * LP + t) * 64 + d;
                        float* o = outb + oo;
                        *(f32x4*)o = v0; *(f32x4*)(o + 4) = v1;
                        const size_t eo = samp ? WS_FVTS / 2 + ((size_t)(b * 8 + h) * 64 + d) * VPS + permt(PAST + t) : WS_FVT / 2 + ((size_t)(b * 8 + h) * 64 + d) * VPP + permt(t);
                        bf16* p = wsb + eo;
                        const int pitch = samp ? VPS : VPP;
#pragma unroll
                        for (int i = 0; i < 4; ++i) { p[(size_t)i * pitch] = f2bf(v0[i]); p[(size_t)(i + 4) * pitch] = f2bf(v1[i]); }
                    } else if (KIND == 7 || KIND == 8) {
#pragma unroll
                        for (int i = 0; i < 4; ++i) { v0[i] = sigmoidf_(v0[i]); v1[i] = sigmoidf_(v1[i]); }
                        const int orow = samp ? NB * SEQ + (r - TOKP) : b * SEQ + t - NMETA;
                        if (samp || t >= NMETA) st8bf((KIND == 7 ? SA : SB) + (size_t)orow * 1024 + sub * 256 + c8, v0, v1);
                    } else {
                        if (c8 < 24) { float* o = SM + (size_t)r * 32 + c8; *(f32x4*)o = v0; *(f32x4*)(o + 4) = v1; }
                    }
                }
            }
    }
    __device__ __forceinline__ void operator()(const f32x4 (&acc)[2][2][4][2], const Unit& u, int wr_, int wc_, int fr_, int fq_) const {
        int wr = wr_, wc = wc_, fr = fr_, fq = fq_; asm volatile("" : "+s"(wr), "+s"(wc), "+v"(fr), "+v"(fq));
        const int pn = u.pn;
        if (pn == 0) body<0>(acc, u, wr, wc, fr, fq, 0);
        else if (pn == 1) body<1>(acc, u, wr, wc, fr, fq, 0);
        else if (pn < 4) body<2>(acc, u, wr, wc, fr, fq, pn - 2);
        else if (pn < 6) body<3>(acc, u, wr, wc, fr, fq, pn - 4);
        else if (pn < 8) body<4>(acc, u, wr, wc, fr, fq, pn - 6);
        else if (pn < 10) body<5>(acc, u, wr, wc, fr, fq, pn - 8);
        else if (pn < 12) body<6>(acc, u, wr, wc, fr, fq, pn - 10);
        else if (pn < 16) body<7>(acc, u, wr, wc, fr, fq, pn - 12);
        else if (pn < 20) body<8>(acc, u, wr, wc, fr, fq, pn - 16);
        else body<9>(acc, u, wr, wc, fr, fq, 0);
    }
};

__device__ __forceinline__ void glaA_unit(const Params& P, LAS unsigned char* L, int uid) {
    unsigned char* ws = P.ws;
    const int tid = threadIdx.x, lane = tid & 63, w = __builtin_amdgcn_readfirstlane(tid >> 6), fr = lane & 15, fq = lane >> 4;
    int r0, ntok, ubase;
    if (uid < 528) { const int s = uid / 33, c = uid - s * 33; r0 = s * LP + (c == 0 ? 0 : NMETA + 64 * (c - 1)); ntok = c == 0 ? 16 : 64; ubase = s * 132 + c; }
    else { const int k = uid - 528; r0 = TOKP + k * 32; ntok = 32; ubase = 2112 + k * 4; }
    const int ustep = uid < 528 ? 33 : 1;
    LAS float* WG = (LAS float*)L;
    LAS float* LA = (LAS float*)(L + 17408);
    LAS float* GT = (LAS float*)(L + 83200);
    LAS bf16* KT = (LAS bf16*)(L + 84224);
    LAS bf16* VT = (LAS bf16*)L;
    const float* SM = (const float*)((const unsigned char*)P.out + DO_SM);
    const bf16* GK = (const bf16*)(ws + WS_GK); const bf16* GV = (const bf16*)(ws + WS_GV);
    for (int i = tid; i < 4352; i += NTHREADS) WG[i] = i < 4096 ? P.in[9][i] : P.in[10][i - 4096];
    __syncthreads();
    {
        const int tok = tid >> 3, dkg = tid & 7;
        if (tok < ntok) {
            const f32x4* g4 = (const f32x4*)(SM + (size_t)(r0 + tok) * 32); const f32x4 ga = g4[0], gb = g4[1], gc = g4[2], gd = g4[3];
            const float glr[16] = {ga[0], ga[1], ga[2], ga[3], gb[0], gb[1], gb[2], gb[3], gc[0], gc[1], gc[2], gc[3], gd[0], gd[1], gd[2], gd[3]};
#pragma unroll 4
            for (int i = 0; i < 32; ++i) { const int dk = dkg + 8 * i; float z = WG[4096 + dk];
#pragma unroll
                for (int rk = 0; rk < 16; ++rk) z += glr[rk] * WG[rk * 256 + dk];
                LA[tok * 257 + dk] = logsig_fast(z) * (1.0f / 16.0f); }
        } else {
#pragma unroll 4
            for (int i = 0; i < 32; ++i) LA[tok * 257 + dkg + 8 * i] = 0.f;
        }
    }
    __syncthreads();
    {
        const int col = tid & 255, half = tid >> 8; float g = 0.f;
        for (int k = 0; k < 32; ++k) { const int tok = half * 32 + k; g += LA[tok * 257 + col]; LA[tok * 257 + col] = g; }
        __syncthreads();
        if (half == 1) { const float base = LA[31 * 257 + col];
            for (int k = 0; k < 32; ++k) LA[(32 + k) * 257 + col] += base;
            const float tot = g + base; GT[col] = tot; ((float*)(ws + WS_GTOT))[(size_t)(ubase + (col >> 6) * ustep) * 64 + (col & 63)] = tot; }
    }
    __syncthreads();
    {
        const int tok = tid & 63, part = tid >> 6, h = part >> 1, dkh0 = (part & 1) * 32;
        LAS bf16* kt = KT + h * 4608;
        if (tok < ntok) {
#pragma unroll
            for (int q = 0; q < 4; ++q) { f32x4 a, b; ld8bf(GK + (size_t)(r0 + tok) * 256 + part * 32 + q * 8, a, b);
#pragma unroll
                for (int i = 0; i < 8; ++i) { const int dkh = dkh0 + q * 8 + i, col = h * 64 + dkh; const float kv = i < 4 ? a[i & 3] : b[i & 3];
                    kt[dkh * 72 + tok] = f2bf(kv * __expf(GT[col] - LA[tok * 257 + col])); } }
        } else {
#pragma unroll 8
            for (int i = 0; i < 32; ++i) kt[(dkh0 + i) * 72 + tok] = 0;
        }
    }
    __syncthreads();
#pragma unroll 2
    for (int j = 0; j < 8; ++j) { const int tk = tid & 63, dv0 = ((tid >> 6) * 8 + j) * 8;
        u32x4 v = (u32x4){0, 0, 0, 0}; if (tk < ntok) v = *(const u32x4*)(GV + (size_t)(r0 + tk) * 512 + dv0);
        VT[(dv0 + 0) * 72 + tk] = (bf16)(v.x & 0xffff); VT[(dv0 + 1) * 72 + tk] = (bf16)(v.x >> 16); VT[(dv0 + 2) * 72 + tk] = (bf16)(v.y & 0xffff); VT[(dv0 + 3) * 72 + tk] = (bf16)(v.y >> 16);
        VT[(dv0 + 4) * 72 + tk] = (bf16)(v.z & 0xffff); VT[(dv0 + 5) * 72 + tk] = (bf16)(v.z >> 16); VT[(dv0 + 6) * 72 + tk] = (bf16)(v.w & 0xffff); VT[(dv0 + 7) * 72 + tk] = (bf16)(v.w >> 16); }
    __syncthreads();
    {
        const int h = w >> 1, nh = w & 1; const LAS bf16* kt = KT + h * 4608; const LAS bf16* vt = VT + (h * 128 + 64 * nh) * 72;
        f32x4 acc[4][4];
#pragma unroll
        for (int mt = 0; mt < 4; ++mt)
#pragma unroll
            for (int j = 0; j < 4; ++j) acc[mt][j] = (f32x4){0.f, 0.f, 0.f, 0.f};
#pragma unroll
        for (int ks = 0; ks < 2; ++ks) { bf16x8 bfr[4];
#pragma unroll
            for (int j = 0; j < 4; ++j) bfr[j] = *(const LAS bf16x8*)(vt + (16 * j + fr) * 72 + 32 * ks + 8 * fq);
#pragma unroll
            for (int mt = 0; mt < 4; ++mt) { const bf16x8 af = *(const LAS bf16x8*)(kt + (16 * mt + fr) * 72 + 32 * ks + 8 * fq);
#pragma unroll
                for (int j = 0; j < 4; ++j) acc[mt][j] = __builtin_amdgcn_mfma_f32_16x16x32_bf16(bfr[j], af, acc[mt][j], 0, 0, 0); } }
        float* U = (float*)(ws + WS_U) + (size_t)(ubase + h * ustep) * 8192 + 64 * nh + 4 * fq;
#pragma unroll
        for (int mt = 0; mt < 4; ++mt)
#pragma unroll
            for (int j = 0; j < 4; ++j) *(f32x4*)(U + (16 * mt + fr) * 128 + 16 * j) = acc[mt][j];
    }
    __syncthreads();
}

__device__ __forceinline__ void cumsum_unit(const Params& P, LAS unsigned char* L, int id) {
    unsigned char* ws = P.ws; const int tid = threadIdx.x, lane = tid & 63, w = tid >> 6;
    LAS float* WS = (LAS float*)L;
    const float* SM = (const float*)((const unsigned char*)P.out + DO_SM);
    const bool samp = id >= 128; const int bh = samp ? id - 128 : id, b = bh >> 3, h = bh & 7; const float bfv = P.in[12][h];
    const int n = samp ? LS : LP, pitch = samp ? VPS : VPP; float* CL = (float*)(ws + (samp ? WS_CLS : WS_CLP)) + (size_t)bh * pitch;
    float v[5]; float run = 0.f; const int base = tid * 5;
#pragma unroll
    for (int i = 0; i < 5; ++i) { const int t = base + i; float x = 0.f;
        if (t < n) {
            if (!samp) { x = logsig(SM[(size_t)(b * LP + t) * 32 + 16 + h] + bfv); P.out[O_LFP + (size_t)bh * LP + t] = x; }
            else if (t < PAST) x = P.in[4][(size_t)bh * PAST + t];
            else { x = logsig(SM[(size_t)(TOKP + b * 32 + t - PAST) * 32 + 16 + h] + bfv); P.out[O_LFS + (size_t)bh * 32 + t - PAST] = x; }
        }
        run += x; v[i] = run; }
    float incl = run;
#pragma unroll
    for (int off = 1; off < 64; off <<= 1) { const float y = __shfl_up(incl, off); if (lane >= off) incl += y; }
    if (lane == 63) WS[w] = incl;
    __syncthreads();
    float pre = 0.f;
#pragma unroll
    for (int k = 0; k < 8; ++k) if (k < w) pre += WS[k];
    const float excl = pre + incl - run;
#pragma unroll
    for (int i = 0; i < 5; ++i) { const int t = base + i; if (t < pitch) CL[t] = (excl + v[i]) * LOG2E; }
    __syncthreads();
}

__device__ __forceinline__ void glaB_unit(const Params& P, LAS unsigned char* L, int sh, bool samp) {
    unsigned char* ws = P.ws;
    const int tid = threadIdx.x, lane = tid & 63, w = __builtin_amdgcn_readfirstlane(tid >> 6), fr = lane & 15, fq = lane >> 4;
    const int s = sh >> 2, h = sh & 3;
    LAS bf16* ST = (LAS bf16*)L;
    LAS float* SSQ = (LAS float*)(L + 73728);
    const bf16* GQ = (const bf16*)((const unsigned char*)P.out + DO_GQ); const bf16* GR = (const bf16*)((const unsigned char*)P.out + DO_GR);
    bf16* YA = (bf16*)(ws + WS_YAB);
    const float* U = (const float*)(ws + WS_U); const float* GTOT = (const float*)(ws + WS_GTOT);
    const int dv = tid & 127, dk0 = (tid >> 7) * 16;
    const int mt = w & 3, nh = w >> 2;
    float st[16];
    const int ncc = samp ? 1 : 4, nstep = samp ? 1 : 8, ntok = samp ? 32 : 64;
    int ubase;
    if (samp) {
#pragma unroll
        for (int i = 0; i < 16; ++i) st[i] = P.in[5][((size_t)sh * 64 + dk0 + i) * 128 + dv];
        ubase = 2112 + sh;
    } else {
        const float* Uc = U + (size_t)(sh * 33) * 8192 + (size_t)dk0 * 128 + dv;
#pragma unroll
        for (int i = 0; i < 16; ++i) st[i] = Uc[i * 128];
        ubase = sh * 33 + 1;
    }
    const bool valid = 16 * mt < ntok;
    for (int it = 0; it < nstep; ++it) {
        const int rA = samp ? TOKP + s * 32 : s * LP + NMETA + 256 * it, oA = samp ? NB * SEQ + s * 32 : s * SEQ + 256 * it;
        {
            float uu[4][16], aa[4][16];
#pragma unroll
            for (int cc = 0; cc < 4; ++cc) if (cc < ncc) { const int uid = ubase + 4 * it + cc; const float* Uc = U + (size_t)uid * 8192 + (size_t)dk0 * 128 + dv; const float* gt = GTOT + (size_t)uid * 64 + dk0;
#pragma unroll
                for (int i = 0; i < 16; ++i) { uu[cc][i] = Uc[i * 128]; aa[cc][i] = gt[i]; } }
#pragma unroll
            for (int cc = 0; cc < 4; ++cc) if (cc < ncc) {
#pragma unroll
                for (int i = 0; i < 16; ++i) st[i] = __expf(aa[cc][i]) * st[i] + uu[cc][i];
                u32x4 w0, w1; w0.x = pk2(st[0], st[1]); w0.y = pk2(st[2], st[3]); w0.z = pk2(st[4], st[5]); w0.w = pk2(st[6], st[7]);
                w1.x = pk2(st[8], st[9]); w1.y = pk2(st[10], st[11]); w1.z = pk2(st[12], st[13]); w1.w = pk2(st[14], st[15]);
                *(LAS u32x4*)(ST + cc * 9216 + dv * 72 + dk0) = w0; *(LAS u32x4*)(ST + cc * 9216 + dv * 72 + dk0 + 8) = w1; }
        }
        const int rowA = rA + 16 * mt + fr;
        bf16x8 qfr[4][2]; u32x2 grv[4][4];
#pragma unroll
        for (int cc = 0; cc < 4; ++cc) {
#pragma unroll
            for (int ks = 0; ks < 2; ++ks) qfr[cc][ks] = (bf16x8){0, 0, 0, 0, 0, 0, 0, 0};
#pragma unroll
            for (int j = 0; j < 4; ++j) grv[cc][j] = (u32x2){0, 0};
            if (valid && cc < ncc) {
                const size_t row = (size_t)rowA + 64 * cc;
#pragma unroll
                for (int ks = 0; ks < 2; ++ks) qfr[cc][ks] = *(const bf16x8*)(GQ + row * 256 + h * 64 + 32 * ks + 8 * fq);
#pragma unroll
                for (int j = 0; j < 4; ++j) grv[cc][j] = *(const u32x2*)(GR + row * 512 + h * 128 + 64 * nh + 16 * j + 4 * fq);
            }
        }
        __syncthreads();
        f32x4 acc[4][4];
#pragma unroll
        for (int cc = 0; cc < 4; ++cc) {
#pragma unroll
            for (int j = 0; j < 4; ++j) acc[cc][j] = (f32x4){0.f, 0.f, 0.f, 0.f};
            if (valid && cc < ncc) {
#pragma unroll
                for (int ks = 0; ks < 2; ++ks)
#pragma unroll
                    for (int j = 0; j < 4; ++j) { const bf16x8 sf = *(const LAS bf16x8*)(ST + cc * 9216 + (16 * (4 * nh + j) + fr) * 72 + 32 * ks + 8 * fq); acc[cc][j] = __builtin_amdgcn_mfma_f32_16x16x32_bf16(sf, qfr[cc][ks], acc[cc][j], 0, 0, 0); }
                float q = 0.f;
#pragma unroll
                for (int j = 0; j < 4; ++j) q += (acc[cc][j][0] * acc[cc][j][0] + acc[cc][j][1] * acc[cc][j][1]) + (acc[cc][j][2] * acc[cc][j][2] + acc[cc][j][3] * acc[cc][j][3]);
                q += __shfl_xor(q, 16); q += __shfl_xor(q, 32);
                if (fq == 0) SSQ[cc * 128 + (16 * mt + fr) * 2 + nh] = q;
            }
        }
        __syncthreads();
#pragma unroll
        for (int cc = 0; cc < 4; ++cc)
            if (valid && cc < ncc) {
                const float rs = 1.0f / sqrtf((SSQ[cc * 128 + (16 * mt + fr) * 2] + SSQ[cc * 128 + (16 * mt + fr) * 2 + 1]) * (1.0f / 128.0f) + EPS);
#pragma unroll
                for (int j = 0; j < 4; ++j) { const u32x2 g = grv[cc][j]; const f32x4 o = acc[cc][j] * rs * *(const f32x4*)(P.in[11] + 64 * nh + 16 * j + 4 * fq);
                    const size_t ooff = (size_t)(oA + 64 * cc + 16 * mt + fr) * 512 + h * 128 + 64 * nh + 16 * j + 4 * fq;
                    *(u32x2*)(YA + ooff) = (u32x2){pk2(o[0] * bflo(g.x), o[1] * bfhi(g.x)), pk2(o[2] * bflo(g.y), o[3] * bfhi(g.y))}; }
            }
    }
    float* so = P.out + (samp ? O_GSS : O_GSP) + ((size_t)sh * 64 + dk0) * 128 + dv;
#pragma unroll
    for (int i = 0; i < 16; ++i) so[i * 128] = st[i];
    __syncthreads();
}

__device__ __forceinline__ void attn_unit(LAS unsigned char* L, const bf16* Q, const bf16* K, const bf16* VT, const float* CL, int vpitch, int q0, int nq, int NT, bf16* Y) {
    const int tid = threadIdx.x, lane = tid & 63, w = __builtin_amdgcn_readfirstlane(tid >> 6), r32 = lane & 31, hi = lane >> 5;
    LAS bf16* KS = (LAS bf16*)L; LAS bf16* VS = (LAS bf16*)(L + 2 * 9216); LAS float* CS = (LAS float*)(L + 4 * 9216);
    const int qrow0 = 32 * w; const bool active = qrow0 < nq;
    bf16x8 qr[4];
#pragma unroll
    for (int d0 = 0; d0 < 4; ++d0) qr[d0] = active ? *(const bf16x8*)(Q + (size_t)(qrow0 + r32) * 64 + d0 * 16 + hi * 8) : (bf16x8){0, 0, 0, 0, 0, 0, 0, 0};
    const int srow = tid >> 3, sch = tid & 7, soff = srow * 72 + sch * 8;
    const bf16* kg = K + (size_t)srow * 64 + sch * 8; const bf16* vg = VT + (size_t)srow * vpitch + sch * 8;
    u32x4 kreg = *(const u32x4*)kg, vreg = *(const u32x4*)vg; float creg = tid < 64 ? CL[tid] : 0.f;
    *(LAS u32x4*)(KS + soff) = kreg; *(LAS u32x4*)(VS + soff) = vreg; if (tid < 64) CS[tid] = creg;
    __syncthreads();
    float mrun = 0.f, lrun = 0.f; f32x16 o0, o1;
#pragma unroll
    for (int r = 0; r < 16; ++r) { o0[r] = 0.f; o1[r] = 0.f; }
    const int wq_first = q0 + qrow0, wq_last = wq_first + 31, qpos = wq_first + r32;
#define ATT_TILE(J, CUR) do { \
        if (active && 64 * (J) <= wq_last) { \
            const LAS bf16* ks = KS + (CUR) * 4608; const LAS bf16* vs = VS + (CUR) * 4608; const LAS float* cs = CS + (CUR) * 64; \
            f32x16 p0, p1; \
        _Pragma("unroll") \
            for (int g = 0; g < 4; ++g) { const f32x4 c0 = *(const LAS f32x4*)(cs + 8 * g + 4 * hi); const f32x4 c1 = *(const LAS f32x4*)(cs + 32 + 8 * g + 4 * hi); \
        _Pragma("unroll") \
                for (int i = 0; i < 4; ++i) { p0[4 * g + i] = -c0[i] - mrun; p1[4 * g + i] = -c1[i] - mrun; } } \
        _Pragma("unroll") \
            for (int d0 = 0; d0 < 4; ++d0) { const bf16x8 k0 = *(const LAS bf16x8*)(ks + r32 * 72 + d0 * 16 + hi * 8); const bf16x8 k1 = *(const LAS bf16x8*)(ks + (32 + r32) * 72 + d0 * 16 + hi * 8); \
                p0 = __builtin_amdgcn_mfma_f32_32x32x16_bf16(k0, qr[d0], p0, 0, 0, 0); p1 = __builtin_amdgcn_mfma_f32_32x32x16_bf16(k1, qr[d0], p1, 0, 0, 0); } \
            if (64 * (J) + 63 > wq_first) { \
        _Pragma("unroll") \
                for (int r = 0; r < 16; ++r) { const int kv = 64 * (J) + crow(r, hi); if (kv > qpos) p0[r] = -INFINITY; if (kv + 32 > qpos) p1[r] = -INFINITY; } \
            } \
            float mx = fmaxf(p0[0], p1[0]); \
        _Pragma("unroll") \
            for (int r = 1; r < 16; ++r) mx = fmaxf(mx, fmaxf(p0[r], p1[r])); \
            mx = fmaxf(mx, __shfl_xor(mx, 32)); \
            if ((J) == 0) { \
                mrun = mx; \
        _Pragma("unroll") \
                for (int r = 0; r < 16; ++r) { p0[r] -= mx; p1[r] -= mx; } \
            } else if (__any(mx > 8.0f)) { \
                const float dl = fmaxf(mx, 0.f), sc = __builtin_amdgcn_exp2f(-dl); mrun += dl; lrun *= sc; \
        _Pragma("unroll") \
                for (int r = 0; r < 16; ++r) { p0[r] -= dl; p1[r] -= dl; o0[r] *= sc; o1[r] *= sc; } \
            } \
            float rs = 0.f; \
        _Pragma("unroll") \
            for (int r = 0; r < 16; ++r) { p0[r] = __builtin_amdgcn_exp2f(p0[r]); p1[r] = __builtin_amdgcn_exp2f(p1[r]); rs += p0[r] + p1[r]; } \
            lrun += rs; \
            u32x4 pw[4]; \
            pw[0] = (u32x4){pk2(p0[0], p0[1]), pk2(p0[2], p0[3]), pk2(p0[4], p0[5]), pk2(p0[6], p0[7])}; \
            pw[1] = (u32x4){pk2(p0[8], p0[9]), pk2(p0[10], p0[11]), pk2(p0[12], p0[13]), pk2(p0[14], p0[15])}; \
            pw[2] = (u32x4){pk2(p1[0], p1[1]), pk2(p1[2], p1[3]), pk2(p1[4], p1[5]), pk2(p1[6], p1[7])}; \
            pw[3] = (u32x4){pk2(p1[8], p1[9]), pk2(p1[10], p1[11]), pk2(p1[12], p1[13]), pk2(p1[14], p1[15])}; \
        _Pragma("unroll") \
            for (int ksx = 0; ksx < 4; ++ksx) { const bf16x8 pf = __builtin_bit_cast(bf16x8, pw[ksx]); \
                const bf16x8 v0 = *(const LAS bf16x8*)(vs + r32 * 72 + 16 * ksx + 8 * hi); const bf16x8 v1 = *(const LAS bf16x8*)(vs + (32 + r32) * 72 + 16 * ksx + 8 * hi); \
                o0 = __builtin_amdgcn_mfma_f32_32x32x16_bf16(v0, pf, o0, 0, 0, 0); o1 = __builtin_amdgcn_mfma_f32_32x32x16_bf16(v1, pf, o1, 0, 0, 0); } \
        } \
    } while (0)
    u32x4 kB = kreg, vB = vreg; float cB = creg;
    if (NT > 1) { kreg = *(const u32x4*)(kg + (size_t)4096); vreg = *(const u32x4*)(vg + 64); if (tid < 64) creg = CL[64 + tid]; }
    for (int j = 0; j < NT; j += 2) {
        if (j + 2 < NT) { kB = *(const u32x4*)(kg + (size_t)(j + 2) * 4096); vB = *(const u32x4*)(vg + (j + 2) * 64); if (tid < 64) cB = CL[(j + 2) * 64 + tid]; }
        ATT_TILE(j, 0);
        if (j + 1 < NT) { *(LAS u32x4*)(KS + 4608 + soff) = kreg; *(LAS u32x4*)(VS + 4608 + soff) = vreg; if (tid < 64) CS[64 + tid] = creg; }
        __syncthreads();
        if (j + 1 >= NT) break;
        if (j + 3 < NT) { kreg = *(const u32x4*)(kg + (size_t)(j + 3) * 4096); vreg = *(const u32x4*)(vg + (j + 3) * 64); if (tid < 64) creg = CL[(j + 3) * 64 + tid]; }
        ATT_TILE(j + 1, 1);
        if (j + 2 < NT) { *(LAS u32x4*)(KS + soff) = kB; *(LAS u32x4*)(VS + soff) = vB; if (tid < 64) CS[tid] = cB; }
        __syncthreads();
    }
#undef ATT_TILE
    if (active) {
        const float lt = lrun + __shfl_xor(lrun, 32); const float inv = 1.0f / lt;
        if (qrow0 + r32 < nq) {
            bf16* yr = Y + (size_t)(qrow0 + r32) * 512;
#pragma unroll
            for (int g = 0; g < 4; ++g) {
                *(u32x2*)(yr + 8 * g + 4 * hi) = (u32x2){pk2(o0[4 * g] * inv, o0[4 * g + 1] * inv), pk2(o0[4 * g + 2] * inv, o0[4 * g + 3] * inv)};
                *(u32x2*)(yr + 32 + 8 * g + 4 * hi) = (u32x2){pk2(o1[4 * g] * inv, o1[4 * g + 1] * inv), pk2(o1[4 * g + 2] * inv, o1[4 * g + 3] * inv)};
            }
        }
    }
}

constexpr int P3_NUNITS = 64 + 1024 + 128 + 64;
__device__ __forceinline__ void p3_unit(const Params& P, LAS unsigned char* L, int idx) {
    unsigned char* ws = P.ws;
    bf16* YB = (bf16*)(ws + WS_YAB) + (size_t)ROWS * 512;
    if (idx < 64) { glaB_unit(P, L, idx, false); return; } idx -= 64;
    if (idx < 1024) { const int i = 8 - (idx >> 7), bh = idx & 127, b = bh >> 3, h = bh & 7, q0 = NMETA + 256 * (i - 1);
        attn_unit(L, (const bf16*)(ws + WS_FQ) + ((size_t)bh * LP + q0) * 64, (const bf16*)(ws + WS_FK) + (size_t)bh * LP * 64, (const bf16*)(ws + WS_FVT) + (size_t)bh * 64 * VPP,
                  (const float*)(ws + WS_CLP) + (size_t)bh * VPP, VPP, q0, 256, 4 * i + 1, YB + ((size_t)b * SEQ + q0 - NMETA) * 512 + h * 64); return; } idx -= 1024;
    if (idx < 128) { const int bh = idx, b = bh >> 3, h = bh & 7;
        attn_unit(L, (const bf16*)(ws + WS_FQS) + (size_t)bh * 32 * 64, (const bf16*)(ws + WS_FKS) + (size_t)bh * LS * 64, (const bf16*)(ws + WS_FVTS) + (size_t)bh * 64 * VPS,
                  (const float*)(ws + WS_CLS) + (size_t)bh * VPS, VPS, PAST, 32, 17, YB + ((size_t)NB * SEQ + b * 32) * 512 + h * 64); return; } idx -= 128;
    glaB_unit(P, L, idx, true);
}

struct RevOrder {
    pg8::StaticOrder S;
    __device__ __forceinline__ bool next(int i, Unit& u) const { Unit t; if (!S.next(i, t)) return false; u.pm = t.pm; u.pn = 20 - t.pn; return true; }
    __device__ __forceinline__ void a_ready(const Unit&) const {}
    __device__ __forceinline__ void done(const Unit&) const {}
};
struct PubOrder {
    pg8::StaticOrder S; unsigned* ready;
    __device__ __forceinline__ bool next(int i, Unit& u) const { return S.next(i, u); }
    __device__ __forceinline__ void a_ready(const Unit&) const {}
    __device__ __forceinline__ void done(const Unit& u) const {
        asm volatile("s_waitcnt vmcnt(0)" ::: "memory");
        if ((threadIdx.x & 63) == 0) __hip_atomic_fetch_add(ready + 64 * u.pm, 1u, __ATOMIC_RELAXED, __HIP_MEMORY_SCOPE_AGENT);
    }
};
struct GateOrder {
    pg8::StaticOrder S; unsigned* ready; unsigned need; mutable int last_pm;
    __device__ __forceinline__ bool next(int i, Unit& u) const { return S.next(i, u); }
    __device__ __forceinline__ void a_ready(const Unit& u) const {
        if (u.pm == last_pm) return;
        last_pm = u.pm;
        if (threadIdx.x < 64) {
            unsigned spins = 0u;
            while ((unsigned)__builtin_amdgcn_readfirstlane((int)__hip_atomic_load(ready + 64 * u.pm, __ATOMIC_RELAXED, __HIP_MEMORY_SCOPE_AGENT)) < need) { __builtin_amdgcn_s_sleep(2); if (++spins > (1u << 20)) break; }
            __builtin_amdgcn_fence(__ATOMIC_ACQUIRE, "agent");
            asm volatile("s_waitcnt vmcnt(0)" ::: "memory");
        }
        asm volatile("" ::: "memory"); __builtin_amdgcn_s_barrier(); asm volatile("" ::: "memory");
    }
    __device__ __forceinline__ void done(const Unit&) const {}
};
struct MergeOrder {
    pg8::StaticOrder S; int pass;
    __device__ __forceinline__ bool next(int i, Unit& u) const { Unit t; if (!S.next(i >> 1, t)) return false; const int p = i & 1; u.pm = t.pm + 130 * p; u.pn = t.pn + 4 * p; u.kofs = 0; u.nt = 0; return true; }
    __device__ __forceinline__ void a_ready(const Unit&) const {}
    __device__ __forceinline__ void done(const Unit&) const {}
};
struct EpiMerge {
    static constexpr bool PERM = true, AFTER_DRAIN = false;
    const bf16 *SA, *SB; bf16 *MT, *Mo;
    __device__ __forceinline__ void operator()(const f32x4 (&acc)[2][2][4][2], const Unit& u, int wr_, int wc_, int fr_, int fq_) const {
        int wr = wr_, wc = wc_, fr = fr_, fq = fq_; asm volatile("" : "+s"(wr), "+s"(wc), "+v"(fr), "+v"(fq));
        const bool p1 = u.pm >= 130; const int pm = p1 ? u.pm - 130 : u.pm, pn = p1 ? u.pn - 4 : u.pn;
#pragma unroll
        for (int ai = 0; ai < 2; ++ai)
#pragma unroll
            for (int m = 0; m < 4; ++m) { const size_t ro = (size_t)(pm * 256 + ai * 128 + wr * 64 + m * 16 + fr) * 1024 + pn * 256 + wc * 32 + 8 * fq;
#pragma unroll
                for (int bj = 0; bj < 2; ++bj) { const size_t off = ro + bj * 128; f32x4 g0, g1; ld8bf((p1 ? SB : SA) + off, g0, g1);
                    f32x4 v0 = acc[ai][bj][m][0] * g0, v1 = acc[ai][bj][m][1] * g1;
                    if (p1) { f32x4 t0, t1; ld8bf(MT + off, t0, t1); st8bf(Mo + off, v0 + t0, v1 + t1); } else st8bf(MT + off, v0, v1); } }
    }
};
struct EpiOut {
    static constexpr bool PERM = true, AFTER_DRAIN = false;
    const float *xp, *xs; float* H2; bf16* H2B; float* SS;
    __device__ __forceinline__ void operator()(const f32x4 (&acc)[2][2][4][2], const Unit& u, int wr_, int wc_, int fr_, int fq_) const {
        int wr = wr_, wc = wc_, fr = fr_, fq = fq_; asm volatile("" : "+s"(wr), "+s"(wc), "+v"(fr), "+v"(fq));
        const __amdgpu_buffer_rsrc_t hb = __builtin_amdgcn_make_buffer_rsrc((void*)H2B, (short)0, ROWS * 1024 * 2, 0x00020000);
#pragma unroll
        for (int ai = 0; ai < 2; ++ai)
#pragma unroll
            for (int m = 0; m < 4; ++m) { const int r = u.pm * 256 + ai * 128 + wr * 64 + m * 16 + fr; const int c0 = u.pn * 256 + wc * 32 + 8 * fq; const float* hr = (r < NB * SEQ ? xp + (size_t)r * DM : xs + (size_t)(r - NB * SEQ) * DM) + c0; float q = 0.f;
#pragma unroll
                for (int bj = 0; bj < 2; ++bj) { const f32x4 v0 = acc[ai][bj][m][0] + *(const f32x4*)(hr + bj * 128), v1 = acc[ai][bj][m][1] + *(const f32x4*)(hr + bj * 128 + 4);
                    const size_t off = (size_t)r * 1024 + c0 + bj * 128; *(f32x4*)(H2 + off) = v0; *(f32x4*)(H2 + off + 4) = v1;
                    { u32x4 w; w.x = pk2(v0[0], v0[1]); w.y = pk2(v0[2], v0[3]); w.z = pk2(v1[0], v1[1]); w.w = pk2(v1[2], v1[3]); __builtin_amdgcn_raw_buffer_store_b128(w, hb, (unsigned)(off * 2), 0, 16); }
                    q += (v0[0] * v0[0] + v0[1] * v0[1]) + (v0[2] * v0[2] + v0[3] * v0[3]) + (v1[0] * v1[0] + v1[1] * v1[1]) + (v1[2] * v1[2] + v1[3] * v1[3]); }
                q += __shfl_xor(q, 16); q += __shfl_xor(q, 32);
                if (fq == 0) __hip_atomic_store(SS + (size_t)r * 16 + u.pn * 4 + wc, q, __ATOMIC_RELAXED, __HIP_MEMORY_SCOPE_AGENT); }
    }
};
struct EpiUp {
    static constexpr bool PERM = true, AFTER_DRAIN = false;
    const float* SS; bf16* UF;
    __device__ __forceinline__ void operator()(const f32x4 (&acc)[2][2][4][2], const Unit& u, int wr_, int wc_, int fr_, int fq_) const {
        int wr = wr_, wc = wc_, fr = fr_, fq = fq_; asm volatile("" : "+s"(wr), "+s"(wc), "+v"(fr), "+v"(fq));
#pragma unroll
        for (int ai = 0; ai < 2; ++ai)
#pragma unroll
            for (int m = 0; m < 4; ++m) { const int r = u.pm * 256 + ai * 128 + wr * 64 + m * 16 + fr; const f32x4* sp = (const f32x4*)(SS + (size_t)r * 16); const f32x4 s0 = sp[0], s1 = sp[1], s2 = sp[2], s3 = sp[3];
                const float ssum = ((s0[0] + s0[1]) + (s0[2] + s0[3])) + ((s1[0] + s1[1]) + (s1[2] + s1[3])) + ((s2[0] + s2[1]) + (s2[2] + s2[3])) + ((s3[0] + s3[1]) + (s3[2] + s3[3]));
                const float rstd = 1.0f / sqrtf(ssum * (1.f / DM) + EPS);
#pragma unroll
                for (int bj = 0; bj < 2; ++bj) { f32x4 v0 = acc[ai][bj][m][0] * rstd, v1 = acc[ai][bj][m][1] * rstd;
#pragma unroll
                    for (int i = 0; i < 4; ++i) { const float a = fmaxf(v0[i], 0.f), b = fmaxf(v1[i], 0.f); v0[i] = a * a; v1[i] = b * b; }
                    st8bf(UF + (size_t)r * FF + u.pn * 256 + bj * 128 + wc * 32 + 8 * fq, v0, v1); } }
    }
};
struct DownOrder {
    pg8::StaticOrder S; int c;
    __device__ __forceinline__ bool next(int i, Unit& u) const {
        if (c < 128) { if (i == 0) { const int lu = c >> 4; u.pm = 128 + (lu >> 2); u.pn = lu & 3; u.kofs = (c & 15) * 512; u.nt = 4; return true; } return S.next(i - 1, u); }
        return S.next(i, u); }
    __device__ __forceinline__ void a_ready(const Unit&) const {}
    __device__ __forceinline__ void done(const Unit&) const {}
};
struct EpiDown {
    static constexpr bool PERM = true, AFTER_DRAIN = false;
    const float* H2; float* out; float* PB;
    __device__ __forceinline__ void operator()(const f32x4 (&acc)[2][2][4][2], const Unit& u, int wr_, int wc_, int fr_, int fq_) const {
        int wr = wr_, wc = wc_, fr = fr_, fq = fq_; asm volatile("" : "+s"(wr), "+s"(wc), "+v"(fr), "+v"(fq));
        if (u.nt != 0) {
            float* dst = PB + ((size_t)(((u.pm - 128) * 4 + u.pn) * 16 + (u.kofs >> 9))) * 65536;
#pragma unroll
            for (int ai = 0; ai < 2; ++ai)
#pragma unroll
                for (int m = 0; m < 4; ++m) { float* rp = dst + (size_t)(ai * 128 + wr * 64 + m * 16 + fr) * 256 + wc * 32 + 8 * fq;
#pragma unroll
                    for (int bj = 0; bj < 2; ++bj) { *(f32x4*)(rp + bj * 128) = acc[ai][bj][m][0]; *(f32x4*)(rp + bj * 128 + 4) = acc[ai][bj][m][1]; } }
            return;
        }
#pragma unroll
        for (int ai = 0; ai < 2; ++ai)
#pragma unroll
            for (int m = 0; m < 4; ++m) { const size_t ro = (size_t)(u.pm * 256 + ai * 128 + wr * 64 + m * 16 + fr) * 1024 + u.pn * 256 + wc * 32 + 8 * fq;
#pragma unroll
                for (int bj = 0; bj < 2; ++bj) { const size_t off = ro + bj * 128; const f32x4 v0 = acc[ai][bj][m][0] + *(const f32x4*)(H2 + off), v1 = acc[ai][bj][m][1] + *(const f32x4*)(H2 + off + 4);
                    *(f32x4*)(out + off) = v0; *(f32x4*)(out + off + 4) = v1; } }
    }
};

#define XB_TMO      128
#define XB_XCNT(j)  (256  + 64 * (j))
#define XB_XSUB(j)  (1280 + 64 * (j))
#define XB_XGEN(j)  (2304 + 64 * (j))
#define XB_TOP      3328
#define XB_TOPGEN   3392
#define XCD_BAR_WORDS 3456
#define XB_SPIN_CAP (1u << 18)

__device__ __forceinline__ unsigned xb_ld(unsigned* p)              { return __hip_atomic_load(p, __ATOMIC_RELAXED, __HIP_MEMORY_SCOPE_AGENT); }
__device__ __forceinline__ unsigned xb_add(unsigned* p, unsigned v) { return __hip_atomic_fetch_add(p, v, __ATOMIC_RELAXED, __HIP_MEMORY_SCOPE_AGENT); }
__device__ __forceinline__ unsigned xb_xcc_id() { return (unsigned)__builtin_amdgcn_s_getreg((3 << 11) | 20) & 0xFu; }
#define XB_SPIN(cond, bar) do { unsigned _sp = 0; while (cond) { __builtin_amdgcn_s_sleep(1); \
    if ((++_sp & 255u) == 0u) { if (xb_ld(&(bar)[XB_TMO])) break; if (_sp > XB_SPIN_CAP) { atomicAdd(&(bar)[XB_TMO], 1u); break; } } } } while (0)

struct XcdBarrier {
    unsigned* bar; unsigned x;
    volatile LAS unsigned* st;
};

__device__ __forceinline__ XcdBarrier xcd_barrier_post(unsigned* bar, volatile LAS unsigned* st) {
    XcdBarrier b; b.bar = bar; b.x = xb_xcc_id(); b.st = st;
    if (threadIdx.x == 0) (void)xb_add(&bar[XB_XCNT(b.x)], 1u);
    return b;
}
__device__ __forceinline__ void xcd_barrier_complete(unsigned* bar, unsigned x, unsigned& nloc, unsigned& nx) {
    const unsigned G = gridDim.x * gridDim.y * gridDim.z;
    unsigned sum, cnt, mine, sp = 0u;
    for (;;) {
        sum = 0u; cnt = 0u; mine = 0u;
#pragma unroll
        for (unsigned j = 0; j < 16; ++j) { const unsigned c = xb_ld(&bar[XB_XCNT(j)]); sum += c; cnt += (c > 0u) ? 1u : 0u; mine = (j == x) ? c : mine; }
        if (sum == G) break;
        __builtin_amdgcn_s_sleep(1);
        if ((++sp & 255u) == 0u) { if (xb_ld(&bar[XB_TMO])) break; if (sp > XB_SPIN_CAP) { atomicAdd(&bar[XB_TMO], 1u); break; } }
    }
    nloc = mine > 0u ? mine : 1u; nx = cnt > 0u ? cnt : 1u;
}

__device__ __forceinline__ void xcd_barrier(const XcdBarrier& b) {
    asm volatile("s_waitcnt vmcnt(0)" ::: "memory");
    __syncthreads();
    if (threadIdx.x == 0) {
        unsigned* bar = b.bar;
        __builtin_amdgcn_s_waitcnt(0);
        unsigned nloc = b.st[0], nx = b.st[1];
        if (nloc == 0u) { xcd_barrier_complete(bar, b.x, nloc, nx); b.st[0] = nloc; b.st[1] = nx; }
        const unsigned old = xb_add(&bar[XB_XSUB(b.x)], 1u);
        const unsigned gen = old / nloc;
        if (old + 1u == (gen + 1u) * nloc) {
            __builtin_amdgcn_fence(__ATOMIC_RELEASE, "agent");
            asm volatile("s_waitcnt vmcnt(0)" ::: "memory");
            const unsigned og = xb_add(&bar[XB_TOP], 1u);
            const unsigned tg = og / nx;
            if (og + 1u == (tg + 1u) * nx) xb_add(&bar[XB_TOPGEN], 1u);
            else XB_SPIN(xb_ld(&bar[XB_TOPGEN]) == tg, bar);
            __builtin_amdgcn_fence(__ATOMIC_ACQUIRE, "agent");
            xb_add(&bar[XB_XGEN(b.x)], 1u);
            asm volatile("s_waitcnt vmcnt(0)" ::: "memory");
        } else {
            XB_SPIN(xb_ld(&bar[XB_XGEN(b.x)]) == gen, bar);
            __builtin_amdgcn_fence(__ATOMIC_ACQUIRE, "agent");
            asm volatile("s_waitcnt vmcnt(0)" ::: "memory");
        }
    }
    __syncthreads();
}


__global__ void __launch_bounds__(NTHREADS, 2) mk_fwd(Params P) {
    extern __shared__ __attribute__((aligned(16))) unsigned char lds_raw[];
    LAS unsigned char* L = (LAS unsigned char*)lds_raw;
    cg::grid_group grid = cg::this_grid();
    unsigned char* ws = P.ws; unsigned char* ob = (unsigned char*)P.out;
    const int tid = threadIdx.x, G = gridDim.x;
    volatile LAS unsigned* xst = (volatile LAS unsigned*)(L + 140032);
    if (tid == 0) { xst[0] = 0u; xst[1] = 0u; }
    __syncthreads();
    const XcdBarrier xbar = xcd_barrier_post((unsigned*)(ws + WS_CTL) + 4096, xst);
    if (gridDim.x == 0x7fffffffu) grid.sync();
#define GRID_SYNC() xcd_barrier(xbar)


#ifndef REP_P0
#define REP_P0 1
#endif
    for (int rep = 0; rep < REP_P0; ++rep) {
    p0_prologue(P, L);
    GRID_SYNC();
    }
#ifndef REP_P1
#define REP_P1 1
#endif
    for (int rep = 0; rep < REP_P1; ++rep) {
    {
        pg8::Gemm g{(const bf16*)(ws + WS_HN), (const bf16*)(ws + WS_WIN), TOK, NIN, DM}; pg8::StaticOrder S; S.init(TOK, NIN, G, (int)blockIdx.x);
        EpiIn E{(bf16*)(ob + DO_GQ), (bf16*)(ws + WS_GK), (bf16*)(ws + WS_GV), (bf16*)(ob + DO_GR), (bf16*)(ob + DO_SA), (bf16*)(ws + WS_SB), (bf16*)ws, (float*)(ob + DO_SM), P.out};
        pg8::gemm_phase<EpiIn, pg8::StaticOrder, PG8_ALIGN, PG8_SP2>(L, g, S, E);
    }
    GRID_SYNC();
    }
#ifndef REP_P2
#define REP_P2 1
#endif
    for (int rep = 0; rep < REP_P2; ++rep) {
    {
        LAS int* QI = (LAS int*)(L + 140000);
        unsigned* ctr = (unsigned*)(ws + WS_CTL) + 8 + rep;
        for (;;) {
            if (tid == 0) QI[0] = (int)atomicAdd(ctr, 1u);
            __syncthreads();
            const int idx = QI[0];
            __syncthreads();
            if (idx >= 544 + 256) break;
            if (idx < 544) glaA_unit(P, L, idx); else cumsum_unit(P, L, idx - 544);
        }
    }
    GRID_SYNC();
    }
#ifndef REP_P3
#define REP_P3 1
#endif
    for (int rep = 0; rep < REP_P3; ++rep) {
    {
        LAS int* QI = (LAS int*)(L + 140000);
        unsigned* ctr = (unsigned*)(ws + WS_CTL) + rep;
        for (;;) {
            if (tid == 0) QI[0] = (int)atomicAdd(ctr, 1u);
            __syncthreads();
            const int idx = QI[0];
            __syncthreads();
            if (idx >= P3_NUNITS) break;
            p3_unit(P, L, idx);
        }
    }
    GRID_SYNC();
    }
#ifndef NO_P4
    {
        EpiMerge E{(const bf16*)(ob + DO_SA), (const bf16*)(ws + WS_SB), (bf16*)(ws + WS_MT), (bf16*)(ob + DO_SA)};
        { pg8::Gemm g{(const bf16*)(ws + WS_YAB), (const bf16*)(ws + WS_WBR), ROWS, DM, 512}; MergeOrder S; S.S.init(ROWS, DM, G, (int)blockIdx.x); S.pass = 0;
          pg8::gemm_phase<EpiMerge, MergeOrder, PG8_ALIGN, PG8_SP2>(L, g, S, E); }
    }
#endif
    GRID_SYNC();
#ifndef NO_P5
    {
#ifdef PROBE_A
        pg8::Gemm g{(const bf16*)(ws + WS_HN), (const bf16*)(ws + WS_WOUT), TOK, DM, DM};
#else
        pg8::Gemm g{(const bf16*)(ob + DO_SA), (const bf16*)(ws + WS_WOUT), ROWS, DM, DM};
#endif
        PubOrder S; S.S.init(ROWS, DM, G, (int)blockIdx.x); S.ready = (unsigned*)(ws + WS_CTL) + 7680;
        EpiOut E{P.in[0], P.in[1], (float*)(ws + WS_H2), (bf16*)(ws + WS_H2B), (float*)(ws + WS_SS2)};
        pg8::gemm_phase<EpiOut, PubOrder, PG8_ALIGN, PG8_SP2>(L, g, S, E);
    }
#endif
#ifndef NO_P6
    {
        pg8::Gemm g{(const bf16*)(ws + WS_H2B), (const bf16*)(ws + WS_WUP), ROWS, FF, DM};
        GateOrder S; S.S.init(ROWS, FF, G, ((int)blockIdx.x + G / 2) % G); S.ready = (unsigned*)(ws + WS_CTL) + 7680; S.need = 32u; S.last_pm = -1;
        EpiUp E{(const float*)(ws + WS_SS2), (bf16*)(ws + WS_UF)};
        pg8::gemm_phase<EpiUp, GateOrder, PG8_ALIGN, PG8_SP2>(L, g, S, E);
    }
#endif
    GRID_SYNC();
#ifndef NO_P7
    {
        pg8::Gemm g{(const bf16*)(ws + WS_UF), (const bf16*)(ws + WS_WDN), NB * SEQ, DM, FF}; DownOrder S; S.S.init(NB * SEQ, DM, G, (int)blockIdx.x); S.c = (int)blockIdx.x;
        EpiDown E{(const float*)(ws + WS_H2), P.out, (float*)(ws + WS_PB)};
        pg8::gemm_phase<EpiDown, DownOrder, PG8_ALIGN, PG8_SP2>(L, g, S, E);
    }
#endif
    GRID_SYNC();
#ifdef PROBE_BASE
    {
        const bf16* Y = (const bf16*)(PROBE_BASE);
        for (size_t i = (size_t)blockIdx.x * NTHREADS + tid; i < (size_t)NB * SEQ * DM + (size_t)TOKS * DM; i += (size_t)G * NTHREADS) P.out[i] = bf2f(Y[i % ((size_t)PROBE_N)]);
    }
#endif
#ifdef REP_SYNC
    for (int rep = 0; rep < REP_SYNC; ++rep) GRID_SYNC();
#endif
#ifndef NO_P8
    {
        const int lane = tid & 63, gw = blockIdx.x * 8 + (tid >> 6), NGW = G * 8;
        f32x4 gf[4];
#pragma unroll
        for (int j = 0; j < 4; ++j) gf[j] = ((const f32x4*)P.in[19])[lane + 64 * j];
        for (int orow = gw; orow < NB * SEQ + TOKS; orow += NGW) {
            f32x4* y = (f32x4*)(P.out + (size_t)orow * DM) + lane; f32x4 v[4]; float q = 0.f;
            if (orow >= NB * SEQ) {
                const int rs = orow - NB * SEQ; const f32x4* h2 = (const f32x4*)((const float*)(ws + WS_H2) + (size_t)orow * DM) + lane;
                const float* pb = (const float*)(ws + WS_PB) + (size_t)((rs >> 8) * 4) * 16 * 65536 + (size_t)(rs & 255) * 256 + 4 * lane;
#pragma unroll
                for (int j = 0; j < 4; ++j) { f32x4 a = h2[64 * j];
#pragma unroll
                    for (int sl = 0; sl < 16; ++sl) a += *(const f32x4*)(pb + (size_t)(j * 16 + sl) * 65536);
                    y[64 * j] = a; }
            }
#pragma unroll
            for (int j = 0; j < 4; ++j) { v[j] = y[64 * j]; q += (v[j].x * v[j].x + v[j].y * v[j].y) + (v[j].z * v[j].z + v[j].w * v[j].w); }
            const float rstd = 1.0f / sqrtf(wave_sum(q) * (1.f / DM) + EPS);
#pragma unroll
            for (int j = 0; j < 4; ++j) y[64 * j] = v[j] * rstd * gf[j];
        }
    }
#endif
}

extern "C" void kernel_launch(void* const* d_in, const int* in_sizes, int n_in, void* d_out, int out_size, void* d_ws, size_t ws_size, hipStream_t stream) {
    static int grid = 0;
    if (grid == 0) {
        if (n_in != 20 || (size_t)out_size != O_END || ws_size < WS_END) { fprintf(stderr, "kernel_launch: unexpected shapes: n_in %d out %d (want %zu) ws %zu (want %zu)\n", n_in, out_size, (size_t)O_END, ws_size, (size_t)WS_END); grid = -1; return; }
        int dev = 0, cus = 0, per_cu = 0;
        hipGetDevice(&dev); hipDeviceGetAttribute(&cus, hipDeviceAttributeMultiprocessorCount, dev);
        if (hipFuncSetAttribute((const void*)mk_fwd, hipFuncAttributeMaxDynamicSharedMemorySize, LDS_BYTES) != hipSuccess) { fprintf(stderr, "kernel_launch: hipFuncSetAttribute failed\n"); grid = -1; return; }
        if (hipOccupancyMaxActiveBlocksPerMultiprocessor(&per_cu, (const void*)mk_fwd, NTHREADS, LDS_BYTES) != hipSuccess || per_cu < 1) { fprintf(stderr, "kernel_launch: occupancy query says %d\n", per_cu); (void)hipGetLastError(); grid = -1; return; }
        grid = cus * (per_cu > 1 ? 1 : per_cu);
    }
    if (grid < 0) return;
    if (hipMemsetAsync((char*)d_ws + WS_CTL, 0, 65536, stream) != hipSuccess) { fprintf(stderr, "kernel_launch: hipMemsetAsync failed\n"); return; }
    Params p{};
    for (int i = 0; i < 20; ++i) p.in[i] = (const float*)d_in[i];
    p.out = (float*)d_out; p.ws = (unsigned char*)d_ws;
    void* args[] = {&p};
    hipError_t e = hipLaunchCooperativeKernel((const void*)mk_fwd, dim3(grid), dim3(NTHREADS), args, LDS_BYTES, stream);
    if (e != hipSuccess) fprintf(stderr, "kernel_launch: cooperative launch failed: %s (grid %d)\n", hipGetErrorString(e), grid);
}
```

```cpp
#include <hip/hip_runtime.h>
#include <hip/hip_cooperative_groups.h>
#include <cstdio>
#include <cstdint>
#include <cmath>
namespace cg = cooperative_groups;
namespace pg8 {
#define PG8_LAS __attribute__((address_space(3)))
typedef unsigned short bf16_t;
typedef short bf16x8 __attribute__((ext_vector_type(8)));
typedef float f32x4 __attribute__((ext_vector_type(4)));
typedef unsigned u32x4 __attribute__((ext_vector_type(4)));
constexpr int BM = 256, BK = 64, HALF = 128, HTB = HALF * BK * 2  , STAGE_BYTES = 8 * HTB, NXCD = 8, WGM = 8;

__host__ __device__ __forceinline__ int lds_byte(int r, int c) { const int st = (r >> 4) * 2 + (c >> 5), rr = r & 15, cc = c & 31, ob = rr * 64 + cc * 2; return st * 1024 + (ob ^ (((ob >> 9) & 1) << 5)); }
__host__ __device__ __forceinline__ void stage_rc(int b, int& R, int& C) { const int st = b / 1024, sb = b % 1024, swz = sb ^ (((sb >> 9) & 1) << 5); R = (st >> 1) * 16 + swz / 64; C = (st & 1) * 32 + (swz % 64) / 2; }
__host__ __device__ __forceinline__ int perm32(int rho) { const int n = rho >> 4, i = rho & 15; return 8 * (i >> 2) + 4 * n + (i & 3); }

struct Unit { int pm, pn, kofs, nt; };
struct Gemm { const bf16_t* A; const bf16_t* Bt; int M, N, K, ld; };

struct StaticOrder {
    int nM, nN, nwg, G, c;
    __host__ __device__ __forceinline__ void init(int M, int N, int G_, int c_) { nM = M / BM; nN = N / BM; nwg = nM * nN; G = G_; c = c_; }
    __host__ __device__ __forceinline__ bool next(int i, Unit& u) const {
        const long L = (long)i * G + c; if (L >= nwg) return false;
        int wgid = (int)L; { const int q = nwg / NXCD, r = nwg % NXCD, xcd = wgid % NXCD, off = wgid / NXCD; wgid = (xcd < r ? xcd * (q + 1) : r * (q + 1) + (xcd - r) * q) + off; }
        const int nig = WGM * nN, gid = wgid / nig, fm = gid * WGM, gsz = (nM - fm) < WGM ? (nM - fm) : WGM;
        u.pm = fm + ((wgid % nig) % gsz); u.pn = (wgid % nig) / gsz; u.kofs = 0; u.nt = 0; return true;
    }
    __device__ __forceinline__ void a_ready(const Unit&) const {}
    __device__ __forceinline__ void done(const Unit&) const {}
};

__device__ __forceinline__ unsigned cvt_pk_bf16(float lo, float hi) { unsigned r; asm volatile("v_cvt_pk_bf16_f32 %0, %1, %2" : "=v"(r) : "v"(lo), "v"(hi)); return r; }
typedef float f32x2 __attribute__((ext_vector_type(2)));
template <class Epi, class Sched, bool ALIGN_EPI = false, bool SP2 = false>
__device__ __forceinline__ void gemm_phase(PG8_LAS unsigned char* lds, const Gemm g, const Sched& S, const Epi& E) {
    int tid_ = threadIdx.x; asm volatile("" : "+v"(tid_));
    const int tid = tid_, wid = __builtin_amdgcn_readfirstlane(tid >> 6), lane = tid & 63, wr = wid >> 2, wc = wid & 3, fr = lane & 15, fq = lane >> 4;
    const int K = g.ld ? g.ld : g.K, nt = g.K / BK;
    unsigned voffA[2], voffB[2];
#pragma unroll
    for (int i = 0; i < 2; ++i) { int R, C; stage_rc(tid * 16 + i * 8192, R, C); const int Rb = Epi::PERM ? ((R & ~31) + perm32(R & 31)) : R;
        voffA[i] = (unsigned)(R * K + C) * 2u; voffB[i] = (unsigned)(Rb * K + C) * 2u; }
    const size_t kstep = (size_t)(BK * 2);
    const size_t hstep = (size_t)HALF * K * 2;
    const size_t tstep = 2 * hstep;
    const unsigned ldsw = (unsigned)wid * 1024u;
    const int aoff = lds_byte(wr * 64 + fr, fq * 8), boff = lds_byte(wc * 32 + fr, fq * 8);
#define PG8_SA(b, h) (((b) * 2 + (h)) * HTB)
#define PG8_SB(b, h) ((4 + (b) * 2 + (h)) * HTB)
#define PG8_STAGE(bufoff, gbase, voff) do { _Pragma("unroll") for (int _i = 0; _i < 2; ++_i) \
        __builtin_amdgcn_global_load_lds((const unsigned*)((const char*)(gbase) + (voff)[_i]), (PG8_LAS unsigned*)(lds + (bufoff) + ldsw + _i * 8192), 16, 0, 0); } while (0)
#define PG8_LDA(dst, b, h) do { _Pragma("unroll") for (int m = 0; m < 4; ++m) _Pragma("unroll") for (int k = 0; k < 2; ++k) dst[m][k] = *(const PG8_LAS bf16x8*)(lds + PG8_SA(b, h) + aoff + m * 2048 + k * 1024); } while (0)
#define PG8_LDB(dst, b, h) do { _Pragma("unroll") for (int n = 0; n < 2; ++n) _Pragma("unroll") for (int k = 0; k < 2; ++k) dst[n][k] = *(const PG8_LAS bf16x8*)(lds + PG8_SB(b, h) + boff + n * 2048 + k * 1024); } while (0)
#define PG8_MMA(ai, bj, At, Bt) do { __builtin_amdgcn_s_setprio(1); _Pragma("unroll") for (int m = 0; m < 4; ++m) _Pragma("unroll") for (int n = 0; n < 2; ++n) _Pragma("unroll") for (int k = 0; k < 2; ++k) \
        acc[ai][bj][m][n] = __builtin_amdgcn_mfma_f32_16x16x32_bf16(Bt[n][k], At[m][k], acc[ai][bj][m][n], 0, 0, 0); __builtin_amdgcn_s_setprio(0); } while (0)
#define PG8_WAIT_V(n) asm volatile("s_waitcnt vmcnt(" #n ")" ::: "memory")
#define PG8_WAIT_L(n) asm volatile("s_waitcnt lgkmcnt(" #n ")" ::: "memory")
#define PG8_BAR __builtin_amdgcn_s_barrier()
#define PG8_SCHED __builtin_amdgcn_sched_barrier(0)
    Unit cur, nxt; int ui = 0;
    if (!S.next(0, cur)) return;
    f32x4 acc[2][2][4][2];
#pragma unroll
    for (int a = 0; a < 2; ++a)
#pragma unroll
        for (int b = 0; b < 2; ++b)
#pragma unroll
            for (int m = 0; m < 4; ++m)
#pragma unroll
                for (int n = 0; n < 2; ++n) acc[a][b][m][n] = (f32x4){0.f, 0.f, 0.f, 0.f};
    bf16x8 At[4][2], B0[2][2], B1[2][2];
    const char* cA = (const char*)g.A + (size_t)cur.pm * tstep + cur.kofs; const char* cB = (const char*)g.Bt + (size_t)cur.pn * tstep + cur.kofs;
    S.a_ready(cur);
    if constexpr (SP2) {
        PG8_STAGE(PG8_SB(0, 0), cB, voffB); PG8_STAGE(PG8_SB(0, 1), cB + hstep, voffB); PG8_STAGE(PG8_SA(0, 0), cA, voffA); PG8_STAGE(PG8_SA(0, 1), cA + hstep, voffA);
        if (wr == 1) PG8_BAR;
        PG8_WAIT_V(2); PG8_BAR;
        PG8_STAGE(PG8_SB(1, 0), cB + kstep, voffB); PG8_STAGE(PG8_SA(1, 0), cA + kstep, voffA); PG8_STAGE(PG8_SB(1, 1), cB + hstep + kstep, voffB);
        PG8_WAIT_V(6); PG8_BAR;
    } else {
        PG8_STAGE(PG8_SB(0, 0), cB, voffB); PG8_STAGE(PG8_SA(0, 0), cA, voffA); PG8_STAGE(PG8_SB(0, 1), cB + hstep, voffB); PG8_STAGE(PG8_SA(0, 1), cA + hstep, voffA);
        if (wr == 1) PG8_BAR;
        PG8_WAIT_V(4); PG8_BAR;
        PG8_STAGE(PG8_SB(1, 0), cB + kstep, voffB); PG8_STAGE(PG8_SA(1, 0), cA + kstep, voffA); PG8_STAGE(PG8_SB(1, 1), cB + hstep + kstep, voffB);
        PG8_WAIT_V(6); PG8_BAR;
    }
    for (;;) {
        const bool has_next = S.next(ui + 1, nxt);
        const char* nA = has_next ? (const char*)g.A + (size_t)nxt.pm * tstep + nxt.kofs : cA; const char* nB = has_next ? (const char*)g.Bt + (size_t)nxt.pn * tstep + nxt.kofs : cB;
        const int nt_u = cur.nt > 0 ? cur.nt : nt;
        for (int t = 0; t < nt_u; t += 2) {
            const bool last = (t == nt_u - 2);
            const char* a1 = cA + (size_t)(t + 1) * kstep;
            const char* a2 = last ? nA : cA + (size_t)(t + 2) * kstep; const char* b2 = last ? nB : cB + (size_t)(t + 2) * kstep;
            const char* a3 = a2 + kstep; const char* b3 = b2 + kstep;
            if (last && has_next) S.a_ready(nxt);
            if constexpr (SP2) {
            PG8_LDB(B0, 0, 0); PG8_LDB(B1, 0, 1); PG8_SCHED; PG8_LDA(At, 0, 0); PG8_STAGE(PG8_SA(1, 1), a1 + hstep, voffA);
            PG8_WAIT_V(8); PG8_WAIT_L(0); PG8_BAR; PG8_MMA(0, 0, At, B0); PG8_MMA(0, 1, At, B1); PG8_BAR; PG8_SCHED;
            PG8_LDA(At, 0, 1); PG8_STAGE(PG8_SB(0, 0), b2, voffB); PG8_STAGE(PG8_SB(0, 1), b2 + hstep, voffB); PG8_STAGE(PG8_SA(0, 0), a2, voffA);
            PG8_WAIT_V(8); PG8_WAIT_L(0); PG8_BAR; PG8_MMA(1, 0, At, B0); PG8_MMA(1, 1, At, B1); PG8_BAR; PG8_SCHED;
            PG8_LDB(B0, 1, 0); PG8_LDB(B1, 1, 1); PG8_SCHED; PG8_LDA(At, 1, 0); PG8_STAGE(PG8_SA(0, 1), a2 + hstep, voffA);
            PG8_WAIT_V(8); PG8_WAIT_L(0); PG8_BAR; PG8_MMA(0, 0, At, B0); PG8_MMA(0, 1, At, B1); PG8_BAR; PG8_SCHED;
            PG8_LDA(At, 1, 1); PG8_STAGE(PG8_SB(1, 0), b3, voffB); PG8_STAGE(PG8_SB(1, 1), b3 + hstep, voffB); PG8_STAGE(PG8_SA(1, 0), a3, voffA);
            PG8_WAIT_V(8); PG8_WAIT_L(0); PG8_BAR; PG8_MMA(1, 0, At, B0); PG8_MMA(1, 1, At, B1); PG8_BAR; PG8_SCHED;
            } else {
            PG8_LDB(B0, 0, 0); PG8_SCHED; PG8_LDA(At, 0, 0); PG8_STAGE(PG8_SA(1, 1), a1 + hstep, voffA);
            PG8_WAIT_L(8); PG8_BAR; PG8_WAIT_L(0); PG8_MMA(0, 0, At, B0); PG8_BAR; PG8_SCHED;
            PG8_LDB(B1, 0, 1); PG8_STAGE(PG8_SB(0, 0), b2, voffB);
            PG8_BAR; PG8_WAIT_L(0); PG8_MMA(0, 1, At, B1); PG8_BAR;
            PG8_LDA(At, 0, 1); PG8_STAGE(PG8_SA(0, 0), a2, voffA);
            PG8_BAR; PG8_WAIT_L(0); PG8_MMA(1, 0, At, B0); PG8_BAR; PG8_SCHED;
            PG8_STAGE(PG8_SB(0, 1), b2 + hstep, voffB);
            PG8_WAIT_V(6); PG8_BAR; PG8_MMA(1, 1, At, B1); PG8_BAR;
            PG8_LDB(B0, 1, 0); PG8_SCHED; PG8_LDA(At, 1, 0); PG8_STAGE(PG8_SA(0, 1), a2 + hstep, voffA);
            PG8_WAIT_L(8); PG8_BAR; PG8_WAIT_L(0); PG8_MMA(0, 0, At, B0); PG8_BAR; PG8_SCHED;
            PG8_LDB(B1, 1, 1); PG8_STAGE(PG8_SB(1, 0), b3, voffB);
            PG8_BAR; PG8_WAIT_L(0); PG8_MMA(0, 1, At, B1); PG8_BAR;
            PG8_LDA(At, 1, 1); PG8_STAGE(PG8_SA(1, 0), a3, voffA);
            PG8_BAR; PG8_WAIT_L(0); PG8_MMA(1, 0, At, B0); PG8_BAR; PG8_SCHED;
            PG8_STAGE(PG8_SB(1, 1), b3 + hstep, voffB);
            PG8_WAIT_V(6); PG8_BAR; PG8_MMA(1, 1, At, B1); PG8_BAR;
            }
        }
        if constexpr (ALIGN_EPI) { if (wr == 0) PG8_BAR; }
        if constexpr (!Epi::AFTER_DRAIN) { E(acc, cur, wr, wc, fr, fq); S.done(cur); }
        if (!has_next) break;
#pragma unroll
        for (int a = 0; a < 2; ++a)
#pragma unroll
            for (int b = 0; b < 2; ++b)
#pragma unroll
                for (int m = 0; m < 4; ++m)
#pragma unroll
                    for (int n = 0; n < 2; ++n) acc[a][b][m][n] = (f32x4){0.f, 0.f, 0.f, 0.f};
        cur = nxt; cA = nA; cB = nB; ++ui;
        if constexpr (ALIGN_EPI) { if (wr == 1) PG8_BAR; }
    }
    PG8_WAIT_V(0);
    if constexpr (!ALIGN_EPI) { if (wr == 0) PG8_BAR; }
    PG8_BAR;
    if constexpr (Epi::AFTER_DRAIN) { E.fused(acc, cur, wr, wc, fr, fq, lds, wid, lane); S.done(cur); }
#undef PG8_SA
#undef PG8_SB
#undef PG8_STAGE
#undef PG8_LDA
#undef PG8_LDB
#undef PG8_MMA
#undef PG8_WAIT_V
#undef PG8_WAIT_L
#undef PG8_BAR
#undef PG8_SCHED
}
}

#ifndef PG8_SP2
#define PG8_SP2 true
#endif
#ifndef PG8_ALIGN
#define PG8_ALIGN true
#endif
#define LAS __attribute__((address_space(3)))
typedef unsigned short bf16;
typedef float f32x4 __attribute__((ext_vector_type(4)));
typedef float f32x16 __attribute__((ext_vector_type(16)));
typedef short bf16x8 __attribute__((ext_vector_type(8)));
typedef unsigned u32x4 __attribute__((ext_vector_type(4)));
typedef unsigned u32x2 __attribute__((ext_vector_type(2)));
using pg8::Unit;

constexpr int DM = 1024, NB = 16, LP = 2064, NMETA = 16, SEQ = 2048, DSQ = 32, PAST = 1024, LS = 1056;
constexpr int TOKP = NB * LP, TOKS = NB * DSQ, TOK = TOKP + TOKS;
constexpr int NIN = 5376, FF = 4096;
constexpr int ROWS = NB * SEQ + TOKS;
constexpr int VPP = 2112, VPS = 1088;
constexpr float EPS = 1e-6f, LOG2E = 1.4426950408889634f, C2 = 0.125f * 1.4426950408889634f;
constexpr int NTHREADS = 512;
constexpr int LDS_BYTES = 147456;

constexpr size_t MiB = 1u << 20;
constexpr size_t WS_CTL = 0;
constexpr size_t WS_SS2 = 1 * MiB;
constexpr size_t WS_GTOT = 3 * MiB + 512 * 1024;
constexpr size_t WS_CLP = 4 * MiB + 256 * 1024, WS_CLS = 5 * MiB + 512 * 1024;
constexpr size_t WS_WIN = 8 * MiB, WS_WBR = WS_WIN + 10 * MiB + 512 * 1024, WS_WOUT = WS_WBR + 2 * MiB, WS_WUP = WS_WOUT + 2 * MiB, WS_WDN = WS_WUP + 8 * MiB;
constexpr size_t D0 = 2 * MiB;
constexpr size_t WS_UF = D0 + 38 * MiB;
constexpr size_t WS_H2 = D0 + 300 * MiB;
constexpr size_t WS_H2B = D0 + 431 * MiB;
constexpr size_t WS_M = D0 + 38 * MiB, WS_MT = D0 + 103 * MiB + 512 * 1024;
constexpr size_t WS_YAB = D0 + 234 * MiB + 512 * 1024;
constexpr size_t WS_SB = D0 + 169 * MiB;
constexpr size_t WS_FQ = D0 + 300 * MiB, WS_FK = D0 + 332 * MiB + 512 * 1024, WS_FVT = D0 + 365 * MiB, WS_FKS = D0 + 398 * MiB, WS_FVTS = D0 + 415 * MiB;
constexpr size_t WS_U = D0 + 432 * MiB + 512 * 1024;
constexpr size_t WS_FQS = D0 + 501 * MiB;
constexpr size_t WS_PB = D0 + 433 * MiB;
constexpr size_t WS_GK = D0 + 38 * MiB, WS_GV = D0 + 54 * MiB + 512 * 1024, WS_HN = D0 + 88 * MiB;
constexpr size_t WS_END = D0 + 502 * MiB;
constexpr size_t DO_SA = 0, DO_GR = 66 * MiB, DO_GQ = 99 * MiB, DO_SM = 116 * MiB;
constexpr size_t O_YP = 0, O_YS = O_YP + (size_t)NB * SEQ * DM, O_KP = O_YS + (size_t)TOKS * DM, O_VP = O_KP + (size_t)128 * LP * 64, O_LFP = O_VP + (size_t)128 * LP * 64,
                 O_GSP = O_LFP + (size_t)128 * LP, O_KS = O_GSP + (size_t)64 * 8192, O_VS = O_KS + (size_t)128 * 32 * 64, O_LFS = O_VS + (size_t)128 * 32 * 64, O_GSS = O_LFS + 128 * 32,
                 O_END = O_GSS + (size_t)64 * 8192;

struct Params { const float* in[20]; float* out; unsigned char* ws; };

#define LDS_WAIT() asm volatile("s_waitcnt lgkmcnt(0)" ::: "memory")
__device__ __forceinline__ float bf2f(unsigned v) { return __uint_as_float(v << 16); }
__device__ __forceinline__ float bflo(unsigned w) { return __uint_as_float(w << 16); }
__device__ __forceinline__ float bfhi(unsigned w) { return __uint_as_float(w & 0xffff0000u); }
typedef float f32x2_t __attribute__((ext_vector_type(2))); typedef __bf16 bf16x2_t __attribute__((ext_vector_type(2)));
__device__ __forceinline__ unsigned pk2(float lo, float hi) { const f32x2_t v = {lo, hi}; const bf16x2_t b = __builtin_convertvector(v, bf16x2_t); return __builtin_bit_cast(unsigned, b); }
__device__ __forceinline__ unsigned short f2bf(float f) { return (unsigned short)(pk2(f, 0.f) & 0xffffu); }
__device__ __forceinline__ float wave_sum(float v) {
#pragma unroll
    for (int o = 1; o < 64; o <<= 1) v += __shfl_xor(v, o);
    return v;
}
__device__ __forceinline__ float logsig(float z) { return fminf(z, 0.f) - log1pf(expf(-fabsf(z))); }
__device__ __forceinline__ float logsig_fast(float z) { return fminf(z, 0.f) - __logf(1.f + __expf(-fabsf(z))); }
__device__ __forceinline__ float sigmoidf_(float x) { return __builtin_amdgcn_rcpf(1.f + __expf(-x)); }
__device__ __forceinline__ int permt(int t) { const int x = t & 15; return (t & ~15) | ((((x >> 2) & 1) << 3) + (x & 3) + ((x >> 3) << 2)); }
__device__ __forceinline__ int crow(int r, int hi) { return (r & 3) + 8 * (r >> 2) + 4 * hi; }
__device__ __forceinline__ void st8bf(bf16* p, f32x4 a, f32x4 b) { u32x4 w; w.x = pk2(a[0], a[1]); w.y = pk2(a[2], a[3]); w.z = pk2(b[0], b[1]); w.w = pk2(b[2], b[3]); *(u32x4*)p = w; }
__device__ __forceinline__ void ld8bf(const bf16* p, f32x4& a, f32x4& b) { const u32x4 w = *(const u32x4*)p; a = (f32x4){bflo(w.x), bfhi(w.x), bflo(w.y), bfhi(w.y)}; b = (f32x4){bflo(w.z), bfhi(w.z), bflo(w.w), bfhi(w.w)}; }

__device__ __forceinline__ const float* hrow(const Params& P, int r) {
    if (r < TOKP) { const int b = r / LP, t = r - b * LP; return t < NMETA ? P.in[6] + (size_t)t * DM : P.in[0] + ((size_t)b * SEQ + (t - NMETA)) * DM; }
    return P.in[1] + (size_t)(r - TOKP) * DM;
}

__device__ __forceinline__ int win_src(int n) {
    if (n < 1536) return n;
    if (n < 3072) return n + 16;
    if (n < 5120) return n + 24;
    const int i = n - 5120; if (i < 16) return 1536 + i; if (i < 24) return 3088 + (i - 16); return -1;
}
__device__ __forceinline__ void tr_item(const float* W, int ldw, int k0, int sc, const float* gk, bf16* WT, int ldk, LAS float* scr, int lane, bool permv) {
#pragma unroll 8
    for (int i = 0; i < 32; ++i) { const int kk = 2 * i + (lane >> 5); float v = sc >= 0 ? W[(size_t)(k0 + kk) * ldw + sc] : 0.f; if (gk) v *= gk[k0 + kk]; scr[kk * 33 + (lane & 31)] = v; }
    LDS_WAIT(); asm volatile("" ::: "memory");
    const int c = lane & 7;
#pragma unroll
    for (int j = 0; j < 4; ++j) { const int n = (lane >> 3) + 8 * j; const LAS float* s = scr + (8 * c) * 33 + n;
        u32x4 o; o.x = pk2(s[0 * 33], s[1 * 33]); o.y = pk2(s[2 * 33], s[3 * 33]); o.z = pk2(s[4 * 33], s[5 * 33]); o.w = pk2(s[6 * 33], s[7 * 33]);
        if (!permv) *(u32x4*)(WT + (size_t)n * ldk + k0 + 8 * c) = o;
        else { const int t0 = k0 + 8 * c, g16 = t0 & ~15, half = (t0 >> 3) & 1; bf16* d = WT + (size_t)n * ldk + g16 + 4 * half; *(u32x2*)d = (u32x2){o.x, o.y}; *(u32x2*)(d + 8) = (u32x2){o.z, o.w}; } }
    LDS_WAIT(); asm volatile("" ::: "memory");
}

__device__ __forceinline__ void tr_block(const float* W, int ldw, int k0, int nsrc0, const float* gk, bf16* WT, int ldk, LAS float* T) {
    const int tid = threadIdx.x;
    f32x4 v[8];
#pragma unroll
    for (int j = 0; j < 8; ++j) { const int idx = tid + 512 * j, row = idx >> 6, c4 = idx & 63;
        if (nsrc0 >= 0) v[j] = *(const f32x4*)(W + (size_t)(k0 + row) * ldw + nsrc0 + 4 * c4);
        else {
#pragma unroll
            for (int e = 0; e < 4; ++e) { const int sc = win_src(5120 + 4 * c4 + e); v[j][e] = sc >= 0 ? W[(size_t)(k0 + row) * ldw + sc] : 0.f; } } }
#pragma unroll
    for (int j = 0; j < 8; ++j) { const int idx = tid + 512 * j, row = idx >> 6, c4 = idx & 63; const float g = gk ? gk[k0 + row] : 1.f; LAS float* t = T + row * 257 + 4 * c4;
        t[0] = v[j][0] * g; t[1] = v[j][1] * g; t[2] = v[j][2] * g; t[3] = v[j][3] * g; }
    __syncthreads();
#pragma unroll
    for (int j = 0; j < 4; ++j) { const int idx = tid + 512 * j, n = idx >> 3, c = idx & 7; const LAS float* t = T + (8 * c) * 257 + n;
        u32x4 o; o.x = pk2(t[0], t[257]); o.y = pk2(t[2 * 257], t[3 * 257]); o.z = pk2(t[4 * 257], t[5 * 257]); o.w = pk2(t[6 * 257], t[7 * 257]);
        *(u32x4*)(WT + (size_t)n * ldk + k0 + 8 * c) = o; }
    __syncthreads();
}

__device__ __forceinline__ void p0_prologue(const Params& P, LAS unsigned char* L) {
    unsigned char* ws = P.ws;
    const int tid = threadIdx.x, lane = tid & 63, wave = __builtin_amdgcn_readfirstlane(tid >> 6);
    const int G = gridDim.x, gw = blockIdx.x * 8 + wave, NGW = G * 8;
    LAS float* scr = (LAS float*)(L + wave * 8448);
    bf16* Win = (bf16*)(ws + WS_WIN); bf16* Wbr = (bf16*)(ws + WS_WBR); bf16* Wout = (bf16*)(ws + WS_WOUT); bf16* Wup = (bf16*)(ws + WS_WUP); bf16* Wdn = (bf16*)(ws + WS_WDN);
    bf16* FVTs = (bf16*)(ws + WS_FVTS);
    {
        constexpr int B_IN = 16 * 21, B_BG = 8 * 4, B_BF = 8 * 4, B_OUT = 16 * 4, B_UP = 16 * 16, B_DN = 64 * 4;
        constexpr int NBLK = B_IN + B_BG + B_BF + B_OUT + B_UP + B_DN;
        LAS float* T = (LAS float*)L;
        for (int b = blockIdx.x; b < NBLK; b += G) {
            int r = b;
            if (r < B_IN) { const int kb = r / 21, nb = r % 21; const int n0 = 256 * nb; const int src = nb == 20 ? -1 : (n0 < 1536 ? n0 : (n0 < 3072 ? n0 + 16 : n0 + 24));
                tr_block(P.in[8], 5144, 64 * kb, src, P.in[7], Win + (size_t)n0 * 1024, 1024, T); continue; } r -= B_IN;
            if (r < B_BG) { const int kb = r / 4, nb = r % 4; tr_block(P.in[13], 1024, 64 * kb, 256 * nb, nullptr, Wbr + (size_t)(256 * nb) * 512, 512, T); continue; } r -= B_BG;
            if (r < B_BF) { const int kb = r / 4, nb = r % 4; tr_block(P.in[14], 1024, 64 * kb, 256 * nb, nullptr, Wbr + (size_t)(1024 + 256 * nb) * 512, 512, T); continue; } r -= B_BF;
            if (r < B_OUT) { const int kb = r / 4, nb = r % 4; tr_block(P.in[15], 1024, 64 * kb, 256 * nb, nullptr, Wout + (size_t)(256 * nb) * 1024, 1024, T); continue; } r -= B_OUT;
            if (r < B_UP) { const int kb = r / 16, nb = r % 16; tr_block(P.in[17], 4096, 64 * kb, 256 * nb, P.in[16], Wup + (size_t)(256 * nb) * 1024, 1024, T); continue; } r -= B_UP;
            { const int kb = r / 4, nb = r % 4; tr_block(P.in[18], 1024, 64 * kb, 256 * nb, nullptr, Wdn + (size_t)(256 * nb) * 4096, 4096, T); }
        }
    }
    constexpr int I_CV = 128 * 32;
    for (int it = gw; it < I_CV; it += NGW) {
        const int c = lane & 31, bh = it / 32, rem = it % 32, kb = rem >> 1, nb = rem & 1;
        tr_item(P.in[3] + (size_t)bh * PAST * 64, 64, 64 * kb, 32 * nb + c, nullptr, FVTs + ((size_t)bh * 64 + 32 * nb) * VPS, VPS, scr, lane, true);
    }
    bf16* HN = (bf16*)(ws + WS_HN);
    for (int r = gw; r < TOK; r += NGW) {
        const f32x4* xr = (const f32x4*)hrow(P, r) + lane; f32x4 v[4]; float s = 0.f;
#pragma unroll
        for (int j = 0; j < 4; ++j) { v[j] = xr[64 * j]; s += (v[j].x * v[j].x + v[j].y * v[j].y) + (v[j].z * v[j].z + v[j].w * v[j].w); }
        const float rstd = 1.0f / sqrtf(wave_sum(s) * (1.f / DM) + EPS);
        u32x2* o = (u32x2*)(HN + (size_t)r * DM) + lane;
#pragma unroll
        for (int j = 0; j < 4; ++j) o[64 * j] = (u32x2){pk2(v[j].x * rstd, v[j].y * rstd), pk2(v[j].z * rstd, v[j].w * rstd)};
    }
    bf16* FKs = (bf16*)(ws + WS_FKS); bf16* FK = (bf16*)(ws + WS_FK); bf16* FVT = (bf16*)(ws + WS_FVT);
    const int gt = blockIdx.x * NTHREADS + tid, NGT = G * NTHREADS;
    for (int ch = gt; ch < 128 * 8192; ch += NGT) { const int bh = ch >> 13, wi = ch & 8191; const f32x4* s = (const f32x4*)(P.in[2] + (size_t)ch * 8); st8bf(FKs + (size_t)bh * LS * 64 + wi * 8, s[0], s[1]); }
    if (gt < 64) ((unsigned*)(ws + WS_CTL))[gt] = 0u;
    for (int i = gt; i < 64 * 64 / 8; i += NGT) { *(u32x4*)(FK + (size_t)128 * LP * 64 + i * 8) = (u32x4){0, 0, 0, 0}; *(u32x4*)(FKs + (size_t)128 * LS * 64 + i * 8) = (u32x4){0, 0, 0, 0}; }
    for (int i = gt; i < 8192 * 6; i += NGT) { const int row = i / 6, c = i % 6; *(u32x4*)(FVT + (size_t)row * VPP + LP + c * 8) = (u32x4){0, 0, 0, 0}; }
    for (int i = gt; i < 8192 * 4; i += NGT) { const int row = i >> 2, c = i & 3; *(u32x4*)(FVTs + (size_t)row * VPS + LS + c * 8) = (u32x4){0, 0, 0, 0}; }
}

struct EpiIn {
    static constexpr bool PERM = true, AFTER_DRAIN = false;
    bf16 *GQ, *GK, *GV, *GR, *SA, *SB, *wsb; float *SM, *outb;
    template <int KIND> __device__ __forceinline__ void body(const f32x4 (&acc)[2][2][4][2], const Unit& u, int wr, int wc, int fr, int fq, int sub) const {
        const bool samp = u.pm >= 129; const int cw = wc * 32 + 8 * fq;
#pragma unroll
        for (int ai = 0; ai < 2; ++ai)
#pragma unroll
            for (int m = 0; m < 4; ++m) {
                const int r = u.pm * 256 + ai * 128 + wr * 64 + m * 16 + fr;
                int b, t; if (!samp) { b = r / LP; t = r - b * LP; } else { const int rs = r - TOKP; b = rs >> 5; t = rs & 31; }
#pragma unroll
                for (int bj = 0; bj < 2; ++bj) {
                    const int c8 = bj * 128 + cw; f32x4 v0 = acc[ai][bj][m][0], v1 = acc[ai][bj][m][1];
                    if (KIND == 0) st8bf(GQ + (size_t)r * 256 + c8, v0 * 0.125f, v1 * 0.125f);
                    else if (KIND == 1) st8bf(GK + (size_t)r * 256 + c8, v0, v1);
                    else if (KIND == 2) st8bf(GV + (size_t)r * 512 + sub * 256 + c8, v0, v1);
                    else if (KIND == 3) {
#pragma unroll
                        for (int i = 0; i < 4; ++i) { v0[i] = v0[i] * sigmoidf_(v0[i]); v1[i] = v1[i] * sigmoidf_(v1[i]); }
                        st8bf(GR + (size_t)r * 512 + sub * 256 + c8, v0, v1);
                    } else if (KIND == 4) {
                        const int h = sub * 4 + (c8 >> 6), d = c8 & 63;
                        const size_t eo = samp ? WS_FQS / 2 + ((size_t)(b * 8 + h) * 32 + t) * 64 + d : WS_FQ / 2 + ((size_t)(b * 8 + h) * LP + t) * 64 + d;
                        st8bf(wsb + eo, v0 * C2, v1 * C2);
                    } else if (KIND == 5) {
                        const int h = sub * 4 + (c8 >> 6), d = c8 & 63;
                        const size_t eo = samp ? WS_FKS / 2 + ((size_t)(b * 8 + h) * LS + PAST + t) * 64 + d : WS_FK / 2 + ((size_t)(b * 8 + h) * LP + t) * 64 + d;
                        const size_t oo = samp ? O_KS + ((size_t)(b * 8 + h) * 32 + t) * 64 + d : O_KP + ((size_t)(b * 8 + h) * LP + t) * 64 + d;
                        float* o = outb + oo;
                        st8bf(wsb + eo, v0, v1); *(f32x4*)o = v0; *(f32x4*)(o + 4) = v1;
                    } else if (KIND == 6) {
                        const int h = sub * 4 + (c8 >> 6), d = c8 & 63;
                        const size_t oo = samp ? O_VS + ((size_t)(b * 8 + h) * 32 + t) * 64 + d : O_VP + ((size_t)(b * 8 + h) * LP + t) * 64 + d;
                        float* o = outb + oo;
                        *(f32x4*)o = v0; *(f32x4*)(o + 4) = v1;
                        const size_t eo = samp ? WS_FVTS / 2 + ((size_t)(b * 8 + h) * 64 + d) * VPS + permt(PAST + t) : WS_FVT / 2 + ((size_t)(b * 8 + h) * 64 + d) * VPP + permt(t);
                        bf16* p = wsb + eo;
                        const int pitch = samp ? VPS : VPP;
#pragma unroll
                        for (int i = 0; i < 4; ++i) { p[(size_t)i * pitch] = f2bf(v0[i]); p[(size_t)(i + 4) * pitch] = f2bf(v1[i]); }
                    } else if (KIND == 7 || KIND == 8) {
#pragma unroll
                        for (int i = 0; i < 4; ++i) { v0[i] = sigmoidf_(v0[i]); v1[i] = sigmoidf_(v1[i]); }
                        const int orow = samp ? NB * SEQ + (r - TOKP) : b * SEQ + t - NMETA;
                        if (samp || t >= NMETA) st8bf((KIND == 7 ? SA : SB) + (size_t)orow * 1024 + sub * 256 + c8, v0, v1);
                    } else {
                        if (c8 < 24) { float* o = SM + (size_t)r * 32 + c8; *(f32x4*)o = v0; *(f32x4*)(o + 4) = v1; }
                    }
                }
            }
    }
    __device__ __forceinline__ void operator()(const f32x4 (&acc)[2][2][4][2], const Unit& u, int wr_, int wc_, int fr_, int fq_) const {
        int wr = wr_, wc = wc_, fr = fr_, fq = fq_; asm volatile("" : "+s"(wr), "+s"(wc), "+v"(fr), "+v"(fq));
        const int pn = u.pn;
        if (pn == 0) body<0>(acc, u, wr, wc, fr, fq, 0);
        else if (pn == 1) body<1>(acc, u, wr, wc, fr, fq, 0);
        else if (pn < 4) body<2>(acc, u, wr, wc, fr, fq, pn - 2);
        else if (pn < 6) body<3>(acc, u, wr, wc, fr, fq, pn - 4);
        else if (pn < 8) body<4>(acc, u, wr, wc, fr, fq, pn - 6);
        else if (pn < 10) body<5>(acc, u, wr, wc, fr, fq, pn - 8);
        else if (pn < 12) body<6>(acc, u, wr, wc, fr, fq, pn - 10);
        else if (pn < 16) body<7>(acc, u, wr, wc, fr, fq, pn - 12);
        else if (pn < 20) body<8>(acc, u, wr, wc, fr, fq, pn - 16);
        else body<9>(acc, u, wr, wc, fr, fq, 0);
    }
};

__device__ __forceinline__ void glaA_unit(const Params& P, LAS unsigned char* L, int uid) {
    unsigned char* ws = P.ws;
    const int tid = threadIdx.x, lane = tid & 63, w = __builtin_amdgcn_readfirstlane(tid >> 6), fr = lane & 15, fq = lane >> 4;
    int r0, ntok, ubase;
    if (uid < 528) { const int s = uid / 33, c = uid - s * 33; r0 = s * LP + (c == 0 ? 0 : NMETA + 64 * (c - 1)); ntok = c == 0 ? 16 : 64; ubase = s * 132 + c; }
    else { const int k = uid - 528; r0 = TOKP + k * 32; ntok = 32; ubase = 2112 + k * 4; }
    const int ustep = uid < 528 ? 33 : 1;
    LAS float* WG = (LAS float*)L;
    LAS float* LA = (LAS float*)(L + 17408);
    LAS float* GT = (LAS float*)(L + 83200);
    LAS bf16* KT = (LAS bf16*)(L + 84224);
    LAS bf16* VT = (LAS bf16*)L;
    const float* SM = (const float*)((const unsigned char*)P.out + DO_SM);
    const bf16* GK = (const bf16*)(ws + WS_GK); const bf16* GV = (const bf16*)(ws + WS_GV);
    for (int i = tid; i < 4352; i += NTHREADS) WG[i] = i < 4096 ? P.in[9][i] : P.in[10][i - 4096];
    __syncthreads();
    {
        const int tok = tid >> 3, dkg = tid & 7;
        if (tok < ntok) {
            const f32x4* g4 = (const f32x4*)(SM + (size_t)(r0 + tok) * 32); const f32x4 ga = g4[0], gb = g4[1], gc = g4[2], gd = g4[3];
            const float glr[16] = {ga[0], ga[1], ga[2], ga[3], gb[0], gb[1], gb[2], gb[3], gc[0], gc[1], gc[2], gc[3], gd[0], gd[1], gd[2], gd[3]};
#pragma unroll 4
            for (int i = 0; i < 32; ++i) { const int dk = dkg + 8 * i; float z = WG[4096 + dk];
#pragma unroll
                for (int rk = 0; rk < 16; ++rk) z += glr[rk] * WG[rk * 256 + dk];
                LA[tok * 257 + dk] = logsig_fast(z) * (1.0f / 16.0f); }
        } else {
#pragma unroll 4
            for (int i = 0; i < 32; ++i) LA[tok * 257 + dkg + 8 * i] = 0.f;
        }
    }
    __syncthreads();
    {
        const int col = tid & 255, half = tid >> 8; float g = 0.f;
        for (int k = 0; k < 32; ++k) { const int tok = half * 32 + k; g += LA[tok * 257 + col]; LA[tok * 257 + col] = g; }
        __syncthreads();
        if (half == 1) { const float base = LA[31 * 257 + col];
            for (int k = 0; k < 32; ++k) LA[(32 + k) * 257 + col] += base;
            const float tot = g + base; GT[col] = tot; ((float*)(ws + WS_GTOT))[(size_t)(ubase + (col >> 6) * ustep) * 64 + (col & 63)] = tot; }
    }
    __syncthreads();
    {
        const int tok = tid & 63, part = tid >> 6, h = part >> 1, dkh0 = (part & 1) * 32;
        LAS bf16* kt = KT + h * 4608;
        if (tok < ntok) {
#pragma unroll
            for (int q = 0; q < 4; ++q) { f32x4 a, b; ld8bf(GK + (size_t)(r0 + tok) * 256 + part * 32 + q * 8, a, b);
#pragma unroll
                for (int i = 0; i < 8; ++i) { const int dkh = dkh0 + q * 8 + i, col = h * 64 + dkh; const float kv = i < 4 ? a[i & 3] : b[i & 3];
                    kt[dkh * 72 + tok] = f2bf(kv * __expf(GT[col] - LA[tok * 257 + col])); } }
        } else {
#pragma unroll 8
            for (int i = 0; i < 32; ++i) kt[(dkh0 + i) * 72 + tok] = 0;
        }
    }
    __syncthreads();
#pragma unroll 2
    for (int j = 0; j < 8; ++j) { const int tk = tid & 63, dv0 = ((tid >> 6) * 8 + j) * 8;
        u32x4 v = (u32x4){0, 0, 0, 0}; if (tk < ntok) v = *(const u32x4*)(GV + (size_t)(r0 + tk) * 512 + dv0);
        VT[(dv0 + 0) * 72 + tk] = (bf16)(v.x & 0xffff); VT[(dv0 + 1) * 72 + tk] = (bf16)(v.x >> 16); VT[(dv0 + 2) * 72 + tk] = (bf16)(v.y & 0xffff); VT[(dv0 + 3) * 72 + tk] = (bf16)(v.y >> 16);
        VT[(dv0 + 4) * 72 + tk] = (bf16)(v.z & 0xffff); VT[(dv0 + 5) * 72 + tk] = (bf16)(v.z >> 16); VT[(dv0 + 6) * 72 + tk] = (bf16)(v.w & 0xffff); VT[(dv0 + 7) * 72 + tk] = (bf16)(v.w >> 16); }
    __syncthreads();
    {
        const int h = w >> 1, nh = w & 1; const LAS bf16* kt = KT + h * 4608; const LAS bf16* vt = VT + (h * 128 + 64 * nh) * 72;
        f32x4 acc[4][4];
#pragma unroll
        for (int mt = 0; mt < 4; ++mt)
#pragma unroll
            for (int j = 0; j < 4; ++j) acc[mt][j] = (f32x4){0.f, 0.f, 0.f, 0.f};
#pragma unroll
        for (int ks = 0; ks < 2; ++ks) { bf16x8 bfr[4];
#pragma unroll
            for (int j = 0; j < 4; ++j) bfr[j] = *(const LAS bf16x8*)(vt + (16 * j + fr) * 72 + 32 * ks + 8 * fq);
#pragma unroll
            for (int mt = 0; mt < 4; ++mt) { const bf16x8 af = *(const LAS bf16x8*)(kt + (16 * mt + fr) * 72 + 32 * ks + 8 * fq);
#pragma unroll
                for (int j = 0; j < 4; ++j) acc[mt][j] = __builtin_amdgcn_mfma_f32_16x16x32_bf16(bfr[j], af, acc[mt][j], 0, 0, 0); } }
        float* U = (float*)(ws + WS_U) + (size_t)(ubase + h * ustep) * 8192 + 64 * nh + 4 * fq;
#pragma unroll
        for (int mt = 0; mt < 4; ++mt)
#pragma unroll
            for (int j = 0; j < 4; ++j) *(f32x4*)(U + (16 * mt + fr) * 128 + 16 * j) = acc[mt][j];
    }
    __syncthreads();
}

__device__ __forceinline__ void cumsum_unit(const Params& P, LAS unsigned char* L, int id) {
    unsigned char* ws = P.ws; const int tid = threadIdx.x, lane = tid & 63, w = tid >> 6;
    LAS float* WS = (LAS float*)L;
    const float* SM = (const float*)((const unsigned char*)P.out + DO_SM);
    const bool samp = id >= 128; const int bh = samp ? id - 128 : id, b = bh >> 3, h = bh & 7; const float bfv = P.in[12][h];
    const int n = samp ? LS : LP, pitch = samp ? VPS : VPP; float* CL = (float*)(ws + (samp ? WS_CLS : WS_CLP)) + (size_t)bh * pitch;
    float v[5]; float run = 0.f; const int base = tid * 5;
#pragma unroll
    for (int i = 0; i < 5; ++i) { const int t = base + i; float x = 0.f;
        if (t < n) {
            if (!samp) { x = logsig(SM[(size_t)(b * LP + t) * 32 + 16 + h] + bfv); P.out[O_LFP + (size_t)bh * LP + t] = x; }
            else if (t < PAST) x = P.in[4][(size_t)bh * PAST + t];
            else { x = logsig(SM[(size_t)(TOKP + b * 32 + t - PAST) * 32 + 16 + h] + bfv); P.out[O_LFS + (size_t)bh * 32 + t - PAST] = x; }
        }
        run += x; v[i] = run; }
    float incl = run;
#pragma unroll
    for (int off = 1; off < 64; off <<= 1) { const float y = __shfl_up(incl, off); if (lane >= off) incl += y; }
    if (lane == 63) WS[w] = incl;
    __syncthreads();
    float pre = 0.f;
#pragma unroll
    for (int k = 0; k < 8; ++k) if (k < w) pre += WS[k];
    const float excl = pre + incl - run;
#pragma unroll
    for (int i = 0; i < 5; ++i) { const int t = base + i; if (t < pitch) CL[t] = (excl + v[i]) * LOG2E; }
    __syncthreads();
}

__device__ __forceinline__ void glaB_unit(const Params& P, LAS unsigned char* L, int sh, bool samp) {
    unsigned char* ws = P.ws;
    const int tid = threadIdx.x, lane = tid & 63, w = __builtin_amdgcn_readfirstlane(tid >> 6), fr = lane & 15, fq = lane >> 4;
    const int s = sh >> 2, h = sh & 3;
    LAS bf16* ST = (LAS bf16*)L;
    LAS float* SSQ = (LAS float*)(L + 73728);
    const bf16* GQ = (const bf16*)((const unsigned char*)P.out + DO_GQ); const bf16* GR = (const bf16*)((const unsigned char*)P.out + DO_GR);
    bf16* YA = (bf16*)(ws + WS_YAB);
    const float* U = (const float*)(ws + WS_U); const float* GTOT = (const float*)(ws + WS_GTOT);
    const int dv = tid & 127, dk0 = (tid >> 7) * 16;
    const int mt = w & 3, nh = w >> 2;
    float st[16];
    const int ncc = samp ? 1 : 4, nstep = samp ? 1 : 8, ntok = samp ? 32 : 64;
    int ubase;
    if (samp) {
#pragma unroll
        for (int i = 0; i < 16; ++i) st[i] = P.in[5][((size_t)sh * 64 + dk0 + i) * 128 + dv];
        ubase = 2112 + sh;
    } else {
        const float* Uc = U + (size_t)(sh * 33) * 8192 + (size_t)dk0 * 128 + dv;
#pragma unroll
        for (int i = 0; i < 16; ++i) st[i] = Uc[i * 128];
        ubase = sh * 33 + 1;
    }
    const bool valid = 16 * mt < ntok;
    for (int it = 0; it < nstep; ++it) {
        const int rA = samp ? TOKP + s * 32 : s * LP + NMETA + 256 * it, oA = samp ? NB * SEQ + s * 32 : s * SEQ + 256 * it;
        {
            float uu[4][16], aa[4][16];
#pragma unroll
            for (int cc = 0; cc < 4; ++cc) if (cc < ncc) { const int uid = ubase + 4 * it + cc; const float* Uc = U + (size_t)uid * 8192 + (size_t)dk0 * 128 + dv; const float* gt = GTOT + (size_t)uid * 64 + dk0;
#pragma unroll
                for (int i = 0; i < 16; ++i) { uu[cc][i] = Uc[i * 128]; aa[cc][i] = gt[i]; } }
#pragma unroll
            for (int cc = 0; cc < 4; ++cc) if (cc < ncc) {
#pragma unroll
                for (int i = 0; i < 16; ++i) st[i] = __expf(aa[cc][i]) * st[i] + uu[cc][i];
                u32x4 w0, w1; w0.x = pk2(st[0], st[1]); w0.y = pk2(st[2], st[3]); w0.z = pk2(st[4], st[5]); w0.w = pk2(st[6], st[7]);
                w1.x = pk2(st[8], st[9]); w1.y = pk2(st[10], st[11]); w1.z = pk2(st[12], st[13]); w1.w = pk2(st[14], st[15]);
                *(LAS u32x4*)(ST + cc * 9216 + dv * 72 + dk0) = w0; *(LAS u32x4*)(ST + cc * 9216 + dv * 72 + dk0 + 8) = w1; }
        }
        const int rowA = rA + 16 * mt + fr;
        bf16x8 qfr[4][2]; u32x2 grv[4][4];
#pragma unroll
        for (int cc = 0; cc < 4; ++cc) {
#pragma unroll
            for (int ks = 0; ks < 2; ++ks) qfr[cc][ks] = (bf16x8){0, 0, 0, 0, 0, 0, 0, 0};
#pragma unroll
            for (int j = 0; j < 4; ++j) grv[cc][j] = (u32x2){0, 0};
            if (valid && cc < ncc) {
                const size_t row = (size_t)rowA + 64 * cc;
#pragma unroll
                for (int ks = 0; ks < 2; ++ks) qfr[cc][ks] = *(const bf16x8*)(GQ + row * 256 + h * 64 + 32 * ks + 8 * fq);
#pragma unroll
                for (int j = 0; j < 4; ++j) grv[cc][j] = *(const u32x2*)(GR + row * 512 + h * 128 + 64 * nh + 16 * j + 4 * fq);
            }
        }
        __syncthreads();
        f32x4 acc[4][4];
#pragma unroll
        for (int cc = 0; cc < 4; ++cc) {
#pragma unroll
            for (int j = 0; j < 4; ++j) acc[cc][j] = (f32x4){0.f, 0.f, 0.f, 0.f};
            if (valid && cc < ncc) {
#pragma unroll
                for (int ks = 0; ks < 2; ++ks)
#pragma unroll
                    for (int j = 0; j < 4; ++j) { const bf16x8 sf = *(const LAS bf16x8*)(ST + cc * 9216 + (16 * (4 * nh + j) + fr) * 72 + 32 * ks + 8 * fq); acc[cc][j] = __builtin_amdgcn_mfma_f32_16x16x32_bf16(sf, qfr[cc][ks], acc[cc][j], 0, 0, 0); }
                float q = 0.f;
#pragma unroll
                for (int j = 0; j < 4; ++j) q += (acc[cc][j][0] * acc[cc][j][0] + acc[cc][j][1] * acc[cc][j][1]) + (acc[cc][j][2] * acc[cc][j][2] + acc[cc][j][3] * acc[cc][j][3]);
                q += __shfl_xor(q, 16); q += __shfl_xor(q, 32);
                if (fq == 0) SSQ[cc * 128 + (16 * mt + fr) * 2 + nh] = q;
            }
        }
        __syncthreads();
#pragma unroll
        for (int cc = 0; cc < 4; ++cc)
            if (valid && cc < ncc) {
                const float rs = 1.0f / sqrtf((SSQ[cc * 128 + (16 * mt + fr) * 2] + SSQ[cc * 128 + (16 * mt + fr) * 2 + 1]) * (1.0f / 128.0f) + EPS);
#pragma unroll
                for (int j = 0; j < 4; ++j) { const u32x2 g = grv[cc][j]; const f32x4 o = acc[cc][j] * rs * *(const f32x4*)(P.in[11] + 64 * nh + 16 * j + 4 * fq);
                    const size_t ooff = (size_t)(oA + 64 * cc + 16 * mt + fr) * 512 + h * 128 + 64 * nh + 16 * j + 4 * fq;
                    *(u32x2*)(YA + ooff) = (u32x2){pk2(o[0] * bflo(g.x), o[1] * bfhi(g.x)), pk2(o[2] * bflo(g.y), o[3] * bfhi(g.y))}; }
            }
    }
    float* so = P.out + (samp ? O_GSS : O_GSP) + ((size_t)sh * 64 + dk0) * 128 + dv;
#pragma unroll
    for (int i = 0; i < 16; ++i) so[i * 128] = st[i];
    __syncthreads();
}

__device__ __forceinline__ void attn_unit(LAS unsigned char* L, const bf16* Q, const bf16* K, const bf16* VT, const float* CL, int vpitch, int q0, int nq, int NT, bf16* Y) {
    const int tid = threadIdx.x, lane = tid & 63, w = __builtin_amdgcn_readfirstlane(tid >> 6), r32 = lane & 31, hi = lane >> 5;
    LAS bf16* KS = (LAS bf16*)L; LAS bf16* VS = (LAS bf16*)(L + 2 * 9216); LAS float* CS = (LAS float*)(L + 4 * 9216);
    const int qrow0 = 32 * w; const bool active = qrow0 < nq;
    bf16x8 qr[4];
#pragma unroll
    for (int d0 = 0; d0 < 4; ++d0) qr[d0] = active ? *(const bf16x8*)(Q + (size_t)(qrow0 + r32) * 64 + d0 * 16 + hi * 8) : (bf16x8){0, 0, 0, 0, 0, 0, 0, 0};
    const int srow = tid >> 3, sch = tid & 7, soff = srow * 72 + sch * 8;
    const bf16* kg = K + (size_t)srow * 64 + sch * 8; const bf16* vg = VT + (size_t)srow * vpitch + sch * 8;
    u32x4 kreg = *(const u32x4*)kg, vreg = *(const u32x4*)vg; float creg = tid < 64 ? CL[tid] : 0.f;
    *(LAS u32x4*)(KS + soff) = kreg; *(LAS u32x4*)(VS + soff) = vreg; if (tid < 64) CS[tid] = creg;
    __syncthreads();
    float mrun = 0.f, lrun = 0.f; f32x16 o0, o1;
#pragma unroll
    for (int r = 0; r < 16; ++r) { o0[r] = 0.f; o1[r] = 0.f; }
    const int wq_first = q0 + qrow0, wq_last = wq_first + 31, qpos = wq_first + r32;
#define ATT_TILE(J, CUR) do { \
        if (active && 64 * (J) <= wq_last) { \
            const LAS bf16* ks = KS + (CUR) * 4608; const LAS bf16* vs = VS + (CUR) * 4608; const LAS float* cs = CS + (CUR) * 64; \
            f32x16 p0, p1; \
        _Pragma("unroll") \
            for (int g = 0; g < 4; ++g) { const f32x4 c0 = *(const LAS f32x4*)(cs + 8 * g + 4 * hi); const f32x4 c1 = *(const LAS f32x4*)(cs + 32 + 8 * g + 4 * hi); \
        _Pragma("unroll") \
                for (int i = 0; i < 4; ++i) { p0[4 * g + i] = -c0[i] - mrun; p1[4 * g + i] = -c1[i] - mrun; } } \
        _Pragma("unroll") \
            for (int d0 = 0; d0 < 4; ++d0) { const bf16x8 k0 = *(const LAS bf16x8*)(ks + r32 * 72 + d0 * 16 + hi * 8); const bf16x8 k1 = *(const LAS bf16x8*)(ks + (32 + r32) * 72 + d0 * 16 + hi * 8); \
                p0 = __builtin_amdgcn_mfma_f32_32x32x16_bf16(k0, qr[d0], p0, 0, 0, 0); p1 = __builtin_amdgcn_mfma_f32_32x32x16_bf16(k1, qr[d0], p1, 0, 0, 0); } \
            if (64 * (J) + 63 > wq_first) { \
        _Pragma("unroll") \
                for (int r = 0; r < 16; ++r) { const int kv = 64 * (J) + crow(r, hi); if (kv > qpos) p0[r] = -INFINITY; if (kv + 32 > qpos) p1[r] = -INFINITY; } \
            } \
            float mx = fmaxf(p0[0], p1[0]); \
        _Pragma("unroll") \
            for (int r = 1; r < 16; ++r) mx = fmaxf(mx, fmaxf(p0[r], p1[r])); \
            mx = fmaxf(mx, __shfl_xor(mx, 32)); \
            if ((J) == 0) { \
                mrun = mx; \
        _Pragma("unroll") \
                for (int r = 0; r < 16; ++r) { p0[r] -= mx; p1[r] -= mx; } \
            } else if (__any(mx > 8.0f)) { \
                const float dl = fmaxf(mx, 0.f), sc = __builtin_amdgcn_exp2f(-dl); mrun += dl; lrun *= sc; \
        _Pragma("unroll") \
                for (int r = 0; r < 16; ++r) { p0[r] -= dl; p1[r] -= dl; o0[r] *= sc; o1[r] *= sc; } \
            } \
            float rs = 0.f; \
        _Pragma("unroll") \
            for (int r = 0; r < 16; ++r) { p0[r] = __builtin_amdgcn_exp2f(p0[r]); p1[r] = __builtin_amdgcn_exp2f(p1[r]); rs += p0[r] + p1[r]; } \
            lrun += rs; \
            u32x4 pw[4]; \
            pw[0] = (u32x4){pk2(p0[0], p0[1]), pk2(p0[2], p0[3]), pk2(p0[4], p0[5]), pk2(p0[6], p0[7])}; \
            pw[1] = (u32x4){pk2(p0[8], p0[9]), pk2(p0[10], p0[11]), pk2(p0[12], p0[13]), pk2(p0[14], p0[15])}; \
            pw[2] = (u32x4){pk2(p1[0], p1[1]), pk2(p1[2], p1[3]), pk2(p1[4], p1[5]), pk2(p1[6], p1[7])}; \
            pw[3] = (u32x4){pk2(p1[8], p1[9]), pk2(p1[10], p1[11]), pk2(p1[12], p1[13]), pk2(p1[14], p1[15])}; \
        _Pragma("unroll") \
            for (int ksx = 0; ksx < 4; ++ksx) { const bf16x8 pf = __builtin_bit_cast(bf16x8, pw[ksx]); \
                const bf16x8 v0 = *(const LAS bf16x8*)(vs + r32 * 72 + 16 * ksx + 8 * hi); const bf16x8 v1 = *(const LAS bf16x8*)(vs + (32 + r32) * 72 + 16 * ksx + 8 * hi); \
                o0 = __builtin_amdgcn_mfma_f32_32x32x16_bf16(v0, pf, o0, 0, 0, 0); o1 = __builtin_amdgcn_mfma_f32_32x32x16_bf16(v1, pf, o1, 0, 0, 0); } \
        } \
    } while (0)
    u32x4 kB = kreg, vB = vreg; float cB = creg;
    if (NT > 1) { kreg = *(const u32x4*)(kg + (size_t)4096); vreg = *(const u32x4*)(vg + 64); if (tid < 64) creg = CL[64 + tid]; }
    for (int j = 0; j < NT; j += 2) {
        if (j + 2 < NT) { kB = *(const u32x4*)(kg + (size_t)(j + 2) * 4096); vB = *(const u32x4*)(vg + (j + 2) * 64); if (tid < 64) cB = CL[(j + 2) * 64 + tid]; }
        ATT_TILE(j, 0);
        if (j + 1 < NT) { *(LAS u32x4*)(KS + 4608 + soff) = kreg; *(LAS u32x4*)(VS + 4608 + soff) = vreg; if (tid < 64) CS[64 + tid] = creg; }
        __syncthreads();
        if (j + 1 >= NT) break;
        if (j + 3 < NT) { kreg = *(const u32x4*)(kg + (size_t)(j + 3) * 4096); vreg = *(const u32x4*)(vg + (j + 3) * 64); if (tid < 64) creg = CL[(j + 3) * 64 + tid]; }
        ATT_TILE(j + 1, 1);
        if (j + 2 < NT) { *(LAS u32x4*)(KS + soff) = kB; *(LAS u32x4*)(VS + soff) = vB; if (tid < 64) CS[tid] = cB; }
        __syncthreads();
    }
#undef ATT_TILE
    if (active) {
        const float lt = lrun + __shfl_xor(lrun, 32); const float inv = 1.0f / lt;
        if (qrow0 + r32 < nq) {
            bf16* yr = Y + (size_t)(qrow0 + r32) * 512;
#pragma unroll
            for (int g = 0; g < 4; ++g) {
                *(u32x2*)(yr + 8 * g + 4 * hi) = (u32x2){pk2(o0[4 * g] * inv, o0[4 * g + 1] * inv), pk2(o0[4 * g + 2] * inv, o0[4 * g + 3] * inv)};
                *(u32x2*)(yr + 32 + 8 * g + 4 * hi) = (u32x2){pk2(o1[4 * g] * inv, o1[4 * g + 1] * inv), pk2(o1[4 * g + 2] * inv, o1[4 * g + 3] * inv)};
            }
        }
    }
}

constexpr int P3_NUNITS = 64 + 1024 + 128 + 64;
__device__ __forceinline__ void p3_unit(const Params& P, LAS unsigned char* L, int idx) {
    unsigned char* ws = P.ws;
    bf16* YB = (bf16*)(ws + WS_YAB) + (size_t)ROWS * 512;
    if (idx < 64) { glaB_unit(P, L, idx, false); return; } idx -= 64;
    if (idx < 1024) { const int i = 8 - (idx >> 7), bh = idx & 127, b = bh >> 3, h = bh & 7, q0 = NMETA + 256 * (i - 1);
        attn_unit(L, (const bf16*)(ws + WS_FQ) + ((size_t)bh * LP + q0) * 64, (const bf16*)(ws + WS_FK) + (size_t)bh * LP * 64, (const bf16*)(ws + WS_FVT) + (size_t)bh * 64 * VPP,
                  (const float*)(ws + WS_CLP) + (size_t)bh * VPP, VPP, q0, 256, 4 * i + 1, YB + ((size_t)b * SEQ + q0 - NMETA) * 512 + h * 64); return; } idx -= 1024;
    if (idx < 128) { const int bh = idx, b = bh >> 3, h = bh & 7;
        attn_unit(L, (const bf16*)(ws + WS_FQS) + (size_t)bh * 32 * 64, (const bf16*)(ws + WS_FKS) + (size_t)bh * LS * 64, (const bf16*)(ws + WS_FVTS) + (size_t)bh * 64 * VPS,
                  (const float*)(ws + WS_CLS) + (size_t)bh * VPS, VPS, PAST, 32, 17, YB + ((size_t)NB * SEQ + b * 32) * 512 + h * 64); return; } idx -= 128;
    glaB_unit(P, L, idx, true);
}

struct RevOrder {
    pg8::StaticOrder S;
    __device__ __forceinline__ bool next(int i, Unit& u) const { Unit t; if (!S.next(i, t)) return false; u.pm = t.pm; u.pn = 20 - t.pn; return true; }
    __device__ __forceinline__ void a_ready(const Unit&) const {}
    __device__ __forceinline__ void done(const Unit&) const {}
};
struct PubOrder {
    pg8::StaticOrder S; unsigned* ready; unsigned* gate; mutable int last_pm;
    __device__ __forceinline__ bool next(int i, Unit& u) const { return S.next(i, u); }
    __device__ __forceinline__ void a_ready(const Unit& u) const {
        if (u.pm == last_pm) return;
        last_pm = u.pm;
        if (threadIdx.x < 64) {
            unsigned spins = 0u;
            while ((unsigned)__builtin_amdgcn_readfirstlane((int)__hip_atomic_load(gate + 16 * u.pm, __ATOMIC_RELAXED, __HIP_MEMORY_SCOPE_AGENT)) < 32u) { __builtin_amdgcn_s_sleep(2); if (++spins > (1u << 20)) break; }
            __builtin_amdgcn_fence(__ATOMIC_ACQUIRE, "agent");
            asm volatile("s_waitcnt vmcnt(0)" ::: "memory");
        }
        asm volatile("" ::: "memory"); __builtin_amdgcn_s_barrier(); asm volatile("" ::: "memory");
    }
    __device__ __forceinline__ void done(const Unit& u) const {
        asm volatile("s_waitcnt vmcnt(0)" ::: "memory");
        if ((threadIdx.x & 63) == 0) __hip_atomic_fetch_add(ready + 64 * u.pm, 1u, __ATOMIC_RELAXED, __HIP_MEMORY_SCOPE_AGENT);
    }
};
struct GateOrder {
    pg8::StaticOrder S; unsigned* ready; unsigned need; mutable int last_pm; unsigned* tot4;
    __device__ __forceinline__ bool next(int i, Unit& u) const { return S.next(i, u); }
    __device__ __forceinline__ void a_ready(const Unit& u) const {
        if (u.pm == last_pm) return;
        const bool first = last_pm < 0;
        last_pm = u.pm;
        if (threadIdx.x < 64) {
            unsigned spins = 0u;
            if (first) while ((unsigned)__builtin_amdgcn_readfirstlane((int)__hip_atomic_load(tot4, __ATOMIC_RELAXED, __HIP_MEMORY_SCOPE_AGENT)) < 520u * 8u) { __builtin_amdgcn_s_sleep(2); if (++spins > (1u << 20)) break; }
            while ((unsigned)__builtin_amdgcn_readfirstlane((int)__hip_atomic_load(ready + 64 * u.pm, __ATOMIC_RELAXED, __HIP_MEMORY_SCOPE_AGENT)) < need) { __builtin_amdgcn_s_sleep(2); if (++spins > (1u << 20)) break; }
            __builtin_amdgcn_fence(__ATOMIC_ACQUIRE, "agent");
            asm volatile("s_waitcnt vmcnt(0)" ::: "memory");
        }
        asm volatile("" ::: "memory"); __builtin_amdgcn_s_barrier(); asm volatile("" ::: "memory");
    }
    __device__ __forceinline__ void done(const Unit&) const {}
};
struct MergeOrder {
    pg8::StaticOrder S; int pass; unsigned* ready;
    __device__ __forceinline__ bool next(int i, Unit& u) const { Unit t; if (!S.next(i >> 1, t)) return false; const int p = i & 1; u.pm = t.pm + 130 * p; u.pn = t.pn + 4 * p; u.kofs = 0; u.nt = 0; return true; }
    __device__ __forceinline__ void a_ready(const Unit&) const {}
    __device__ __forceinline__ void done(const Unit& u) const {
        if (u.pm >= 130) { asm volatile("s_waitcnt vmcnt(0)" ::: "memory");
            if ((threadIdx.x & 63) == 0) { __hip_atomic_fetch_add(ready + 16 * (u.pm - 130), 1u, __ATOMIC_RELAXED, __HIP_MEMORY_SCOPE_AGENT); __hip_atomic_fetch_add(ready - 16, 1u, __ATOMIC_RELAXED, __HIP_MEMORY_SCOPE_AGENT); } }
    }
};
struct EpiMerge {
    static constexpr bool PERM = true, AFTER_DRAIN = false;
    const bf16 *SA, *SB; bf16 *MT, *Mo;
    __device__ __forceinline__ void operator()(const f32x4 (&acc)[2][2][4][2], const Unit& u, int wr_, int wc_, int fr_, int fq_) const {
        int wr = wr_, wc = wc_, fr = fr_, fq = fq_; asm volatile("" : "+s"(wr), "+s"(wc), "+v"(fr), "+v"(fq));
        const bool p1 = u.pm >= 130; const int pm = p1 ? u.pm - 130 : u.pm, pn = p1 ? u.pn - 4 : u.pn;
        const __amdgpu_buffer_rsrc_t mb = __builtin_amdgcn_make_buffer_rsrc((void*)Mo, (short)0, ROWS * 1024 * 2, 0x00020000);
#pragma unroll
        for (int ai = 0; ai < 2; ++ai)
#pragma unroll
            for (int m = 0; m < 4; ++m) { const size_t ro = (size_t)(pm * 256 + ai * 128 + wr * 64 + m * 16 + fr) * 1024 + pn * 256 + wc * 32 + 8 * fq;
#pragma unroll
                for (int bj = 0; bj < 2; ++bj) { const size_t off = ro + bj * 128; f32x4 g0, g1; ld8bf((p1 ? SB : SA) + off, g0, g1);
                    f32x4 v0 = acc[ai][bj][m][0] * g0, v1 = acc[ai][bj][m][1] * g1;
                    if (p1) { f32x4 t0, t1; ld8bf(MT + off, t0, t1); v0 += t0; v1 += t1; u32x4 w; w.x = pk2(v0[0], v0[1]); w.y = pk2(v0[2], v0[3]); w.z = pk2(v1[0], v1[1]); w.w = pk2(v1[2], v1[3]);
                        __builtin_amdgcn_raw_buffer_store_b128(w, mb, (unsigned)(off * 2), 0, 16); }
                    else st8bf(MT + off, v0, v1); } }
    }
};
struct EpiOut {
    static constexpr bool PERM = true, AFTER_DRAIN = false;
    const float *xp, *xs; float* H2; bf16* H2B; float* SS;
    __device__ __forceinline__ void operator()(const f32x4 (&acc)[2][2][4][2], const Unit& u, int wr_, int wc_, int fr_, int fq_) const {
        int wr = wr_, wc = wc_, fr = fr_, fq = fq_; asm volatile("" : "+s"(wr), "+s"(wc), "+v"(fr), "+v"(fq));
        const __amdgpu_buffer_rsrc_t hb = __builtin_amdgcn_make_buffer_rsrc((void*)H2B, (short)0, ROWS * 1024 * 2, 0x00020000);
#pragma unroll
        for (int ai = 0; ai < 2; ++ai)
#pragma unroll
            for (int m = 0; m < 4; ++m) { const int r = u.pm * 256 + ai * 128 + wr * 64 + m * 16 + fr; const int c0 = u.pn * 256 + wc * 32 + 8 * fq; const float* hr = (r < NB * SEQ ? xp + (size_t)r * DM : xs + (size_t)(r - NB * SEQ) * DM) + c0; float q = 0.f;
#pragma unroll
                for (int bj = 0; bj < 2; ++bj) { const f32x4 v0 = acc[ai][bj][m][0] + *(const f32x4*)(hr + bj * 128), v1 = acc[ai][bj][m][1] + *(const f32x4*)(hr + bj * 128 + 4);
                    const size_t off = (size_t)r * 1024 + c0 + bj * 128; *(f32x4*)(H2 + off) = v0; *(f32x4*)(H2 + off + 4) = v1;
                    { u32x4 w; w.x = pk2(v0[0], v0[1]); w.y = pk2(v0[2], v0[3]); w.z = pk2(v1[0], v1[1]); w.w = pk2(v1[2], v1[3]); __builtin_amdgcn_raw_buffer_store_b128(w, hb, (unsigned)(off * 2), 0, 16); }
                    q += (v0[0] * v0[0] + v0[1] * v0[1]) + (v0[2] * v0[2] + v0[3] * v0[3]) + (v1[0] * v1[0] + v1[1] * v1[1]) + (v1[2] * v1[2] + v1[3] * v1[3]); }
                q += __shfl_xor(q, 16); q += __shfl_xor(q, 32);
                if (fq == 0) __hip_atomic_store(SS + (size_t)r * 16 + u.pn * 4 + wc, q, __ATOMIC_RELAXED, __HIP_MEMORY_SCOPE_AGENT); }
    }
};
struct EpiUp {
    static constexpr bool PERM = true, AFTER_DRAIN = false;
    const float* SS; bf16* UF;
    __device__ __forceinline__ void operator()(const f32x4 (&acc)[2][2][4][2], const Unit& u, int wr_, int wc_, int fr_, int fq_) const {
        int wr = wr_, wc = wc_, fr = fr_, fq = fq_; asm volatile("" : "+s"(wr), "+s"(wc), "+v"(fr), "+v"(fq));
#pragma unroll
        for (int ai = 0; ai < 2; ++ai)
#pragma unroll
            for (int m = 0; m < 4; ++m) { const int r = u.pm * 256 + ai * 128 + wr * 64 + m * 16 + fr; const f32x4* sp = (const f32x4*)(SS + (size_t)r * 16); const f32x4 s0 = sp[0], s1 = sp[1], s2 = sp[2], s3 = sp[3];
                const float ssum = ((s0[0] + s0[1]) + (s0[2] + s0[3])) + ((s1[0] + s1[1]) + (s1[2] + s1[3])) + ((s2[0] + s2[1]) + (s2[2] + s2[3])) + ((s3[0] + s3[1]) + (s3[2] + s3[3]));
                const float rstd = 1.0f / sqrtf(ssum * (1.f / DM) + EPS);
#pragma unroll
                for (int bj = 0; bj < 2; ++bj) { f32x4 v0 = acc[ai][bj][m][0] * rstd, v1 = acc[ai][bj][m][1] * rstd;
#pragma unroll
                    for (int i = 0; i < 4; ++i) { const float a = fmaxf(v0[i], 0.f), b = fmaxf(v1[i], 0.f); v0[i] = a * a; v1[i] = b * b; }
                    st8bf(UF + (size_t)r * FF + u.pn * 256 + bj * 128 + wc * 32 + 8 * fq, v0, v1); } }
    }
};
struct DownOrder {
    pg8::StaticOrder S; int c;
    __device__ __forceinline__ bool next(int i, Unit& u) const {
        if (c < 128) { if (i == 0) { const int lu = c >> 4; u.pm = 128 + (lu >> 2); u.pn = lu & 3; u.kofs = (c & 15) * 512; u.nt = 4; return true; } return S.next(i - 1, u); }
        return S.next(i, u); }
    __device__ __forceinline__ void a_ready(const Unit&) const {}
    __device__ __forceinline__ void done(const Unit&) const {}
};
struct EpiDown {
    static constexpr bool PERM = true, AFTER_DRAIN = false;
    const float* H2; float* out; float* PB;
    __device__ __forceinline__ void operator()(const f32x4 (&acc)[2][2][4][2], const Unit& u, int wr_, int wc_, int fr_, int fq_) const {
        int wr = wr_, wc = wc_, fr = fr_, fq = fq_; asm volatile("" : "+s"(wr), "+s"(wc), "+v"(fr), "+v"(fq));
        if (u.nt != 0) {
            float* dst = PB + ((size_t)(((u.pm - 128) * 4 + u.pn) * 16 + (u.kofs >> 9))) * 65536;
#pragma unroll
            for (int ai = 0; ai < 2; ++ai)
#pragma unroll
                for (int m = 0; m < 4; ++m) { float* rp = dst + (size_t)(ai * 128 + wr * 64 + m * 16 + fr) * 256 + wc * 32 + 8 * fq;
#pragma unroll
                    for (int bj = 0; bj < 2; ++bj) { *(f32x4*)(rp + bj * 128) = acc[ai][bj][m][0]; *(f32x4*)(rp + bj * 128 + 4) = acc[ai][bj][m][1]; } }
            return;
        }
#pragma unroll
        for (int ai = 0; ai < 2; ++ai)
#pragma unroll
            for (int m = 0; m < 4; ++m) { const size_t ro = (size_t)(u.pm * 256 + ai * 128 + wr * 64 + m * 16 + fr) * 1024 + u.pn * 256 + wc * 32 + 8 * fq;
#pragma unroll
                for (int bj = 0; bj < 2; ++bj) { const size_t off = ro + bj * 128; const f32x4 v0 = acc[ai][bj][m][0] + *(const f32x4*)(H2 + off), v1 = acc[ai][bj][m][1] + *(const f32x4*)(H2 + off + 4);
                    *(f32x4*)(out + off) = v0; *(f32x4*)(out + off + 4) = v1; } }
    }
};

#define XB_TMO      128
#define XB_XCNT(j)  (256  + 64 * (j))
#define XB_XSUB(j)  (1280 + 64 * (j))
#define XB_XGEN(j)  (2304 + 64 * (j))
#define XB_TOP      3328
#define XB_TOPGEN   3392
#define XCD_BAR_WORDS 3456
#define XB_SPIN_CAP (1u << 18)

__device__ __forceinline__ unsigned xb_ld(unsigned* p)              { return __hip_atomic_load(p, __ATOMIC_RELAXED, __HIP_MEMORY_SCOPE_AGENT); }
__device__ __forceinline__ unsigned xb_add(unsigned* p, unsigned v) { return __hip_atomic_fetch_add(p, v, __ATOMIC_RELAXED, __HIP_MEMORY_SCOPE_AGENT); }
__device__ __forceinline__ unsigned xb_xcc_id() { return (unsigned)__builtin_amdgcn_s_getreg((3 << 11) | 20) & 0xFu; }
#define XB_SPIN(cond, bar) do { unsigned _sp = 0; while (cond) { __builtin_amdgcn_s_sleep(1); \
    if ((++_sp & 255u) == 0u) { if (xb_ld(&(bar)[XB_TMO])) break; if (_sp > XB_SPIN_CAP) { atomicAdd(&(bar)[XB_TMO], 1u); break; } } } } while (0)

struct XcdBarrier {
    unsigned* bar; unsigned x;
    volatile LAS unsigned* st;
};

__device__ __forceinline__ XcdBarrier xcd_barrier_post(unsigned* bar, volatile LAS unsigned* st) {
    XcdBarrier b; b.bar = bar; b.x = xb_xcc_id(); b.st = st;
    if (threadIdx.x == 0) (void)xb_add(&bar[XB_XCNT(b.x)], 1u);
    return b;
}
__device__ __forceinline__ void xcd_barrier_complete(unsigned* bar, unsigned x, unsigned& nloc, unsigned& nx) {
    const unsigned G = gridDim.x * gridDim.y * gridDim.z;
    unsigned sum, cnt, mine, sp = 0u;
    for (;;) {
        sum = 0u; cnt = 0u; mine = 0u;
#pragma unroll
        for (unsigned j = 0; j < 16; ++j) { const unsigned c = xb_ld(&bar[XB_XCNT(j)]); sum += c; cnt += (c > 0u) ? 1u : 0u; mine = (j == x) ? c : mine; }
        if (sum == G) break;
        __builtin_amdgcn_s_sleep(1);
        if ((++sp & 255u) == 0u) { if (xb_ld(&bar[XB_TMO])) break; if (sp > XB_SPIN_CAP) { atomicAdd(&bar[XB_TMO], 1u); break; } }
    }
    nloc = mine > 0u ? mine : 1u; nx = cnt > 0u ? cnt : 1u;
}

__device__ __forceinline__ void xcd_barrier(const XcdBarrier& b) {
    asm volatile("s_waitcnt vmcnt(0)" ::: "memory");
    __syncthreads();
    if (threadIdx.x == 0) {
        unsigned* bar = b.bar;
        __builtin_amdgcn_s_waitcnt(0);
        unsigned nloc = b.st[0], nx = b.st[1];
        if (nloc == 0u) { xcd_barrier_complete(bar, b.x, nloc, nx); b.st[0] = nloc; b.st[1] = nx; }
        const unsigned old = xb_add(&bar[XB_XSUB(b.x)], 1u);
        const unsigned gen = old / nloc;
        if (old + 1u == (gen + 1u) * nloc) {
            __builtin_amdgcn_fence(__ATOMIC_RELEASE, "agent");
            asm volatile("s_waitcnt vmcnt(0)" ::: "memory");
            const unsigned og = xb_add(&bar[XB_TOP], 1u);
            const unsigned tg = og / nx;
            if (og + 1u == (tg + 1u) * nx) xb_add(&bar[XB_TOPGEN], 1u);
            else XB_SPIN(xb_ld(&bar[XB_TOPGEN]) == tg, bar);
            __builtin_amdgcn_fence(__ATOMIC_ACQUIRE, "agent");
            xb_add(&bar[XB_XGEN(b.x)], 1u);
            asm volatile("s_waitcnt vmcnt(0)" ::: "memory");
        } else {
            XB_SPIN(xb_ld(&bar[XB_XGEN(b.x)]) == gen, bar);
            __builtin_amdgcn_fence(__ATOMIC_ACQUIRE, "agent");
            asm volatile("s_waitcnt vmcnt(0)" ::: "memory");
        }
    }
    __syncthreads();
}


__global__ void __launch_bounds__(NTHREADS, 2) mk_fwd(Params P) {
    extern __shared__ __attribute__((aligned(16))) unsigned char lds_raw[];
    LAS unsigned char* L = (LAS unsigned char*)lds_raw;
    cg::grid_group grid = cg::this_grid();
    unsigned char* ws = P.ws; unsigned char* ob = (unsigned char*)P.out;
    const int tid = threadIdx.x, G = gridDim.x;
    volatile LAS unsigned* xst = (volatile LAS unsigned*)(L + 140032);
    if (tid == 0) { xst[0] = 0u; xst[1] = 0u; }
    __syncthreads();
    const XcdBarrier xbar = xcd_barrier_post((unsigned*)(ws + WS_CTL) + 4096, xst);
    if (gridDim.x == 0x7fffffffu) grid.sync();
#define GRID_SYNC() xcd_barrier(xbar)


#ifndef REP_P0
#define REP_P0 1
#endif
    for (int rep = 0; rep < REP_P0; ++rep) {
    p0_prologue(P, L);
    GRID_SYNC();
    }
#ifndef REP_P1
#define REP_P1 1
#endif
    for (int rep = 0; rep < REP_P1; ++rep) {
    {
        pg8::Gemm g{(const bf16*)(ws + WS_HN), (const bf16*)(ws + WS_WIN), TOK, NIN, DM}; pg8::StaticOrder S; S.init(TOK, NIN, G, (int)blockIdx.x);
        EpiIn E{(bf16*)(ob + DO_GQ), (bf16*)(ws + WS_GK), (bf16*)(ws + WS_GV), (bf16*)(ob + DO_GR), (bf16*)(ob + DO_SA), (bf16*)(ws + WS_SB), (bf16*)ws, (float*)(ob + DO_SM), P.out};
        pg8::gemm_phase<EpiIn, pg8::StaticOrder, PG8_ALIGN, PG8_SP2>(L, g, S, E);
    }
    GRID_SYNC();
    }
#ifndef REP_P2
#define REP_P2 1
#endif
    for (int rep = 0; rep < REP_P2; ++rep) {
    {
        LAS int* QI = (LAS int*)(L + 140000);
        unsigned* ctr = (unsigned*)(ws + WS_CTL) + 8 + rep;
        for (;;) {
            if (tid == 0) QI[0] = (int)atomicAdd(ctr, 1u);
            __syncthreads();
            const int idx = QI[0];
            __syncthreads();
            if (idx >= 544 + 256) break;
            if (idx < 544) glaA_unit(P, L, idx); else cumsum_unit(P, L, idx - 544);
        }
    }
    GRID_SYNC();
    }
#ifndef REP_P3
#define REP_P3 1
#endif
    for (int rep = 0; rep < REP_P3; ++rep) {
    {
        LAS int* QI = (LAS int*)(L + 140000);
        unsigned* ctr = (unsigned*)(ws + WS_CTL) + rep;
        for (;;) {
            if (tid == 0) QI[0] = (int)atomicAdd(ctr, 1u);
            __syncthreads();
            const int idx = QI[0];
            __syncthreads();
            if (idx >= P3_NUNITS) break;
            p3_unit(P, L, idx);
        }
    }
    GRID_SYNC();
    }
#ifndef NO_P4
    {
        EpiMerge E{(const bf16*)(ob + DO_SA), (const bf16*)(ws + WS_SB), (bf16*)(ws + WS_MT), (bf16*)(ob + DO_SA)};
        { pg8::Gemm g{(const bf16*)(ws + WS_YAB), (const bf16*)(ws + WS_WBR), ROWS, DM, 512}; MergeOrder S; S.S.init(ROWS, DM, G, (int)blockIdx.x); S.pass = 0; S.ready = (unsigned*)(ws + WS_CTL) + 96;
          pg8::gemm_phase<EpiMerge, MergeOrder, PG8_ALIGN, PG8_SP2>(L, g, S, E); }
    }
#endif
#ifndef NO_P5
    {
#ifdef PROBE_A
        pg8::Gemm g{(const bf16*)(ws + WS_HN), (const bf16*)(ws + WS_WOUT), TOK, DM, DM};
#else
        pg8::Gemm g{(const bf16*)(ob + DO_SA), (const bf16*)(ws + WS_WOUT), ROWS, DM, DM};
#endif
        PubOrder S; S.S.init(ROWS, DM, G, ((int)blockIdx.x + G / 2) % G); S.ready = (unsigned*)(ws + WS_CTL) + 7680; S.gate = (unsigned*)(ws + WS_CTL) + 96; S.last_pm = -1;
        EpiOut E{P.in[0], P.in[1], (float*)(ws + WS_H2), (bf16*)(ws + WS_H2B), (float*)(ws + WS_SS2)};
        pg8::gemm_phase<EpiOut, PubOrder, PG8_ALIGN, PG8_SP2>(L, g, S, E);
    }
#endif
#ifndef NO_P6
    {
        pg8::Gemm g{(const bf16*)(ws + WS_H2B), (const bf16*)(ws + WS_WUP), ROWS, FF, DM};
        GateOrder S; S.S.init(ROWS, FF, G, ((int)blockIdx.x + G / 4) % G); S.ready = (unsigned*)(ws + WS_CTL) + 7680; S.need = 32u; S.last_pm = -1; S.tot4 = (unsigned*)(ws + WS_CTL) + 80;
        EpiUp E{(const float*)(ws + WS_SS2), (bf16*)(ws + WS_UF)};
        pg8::gemm_phase<EpiUp, GateOrder, PG8_ALIGN, PG8_SP2>(L, g, S, E);
    }
#endif
    GRID_SYNC();
#ifndef NO_P7
    {
        pg8::Gemm g{(const bf16*)(ws + WS_UF), (const bf16*)(ws + WS_WDN), NB * SEQ, DM, FF}; DownOrder S; S.S.init(NB * SEQ, DM, G, (int)blockIdx.x); S.c = (int)blockIdx.x;
        EpiDown E{(const float*)(ws + WS_H2), P.out, (float*)(ws + WS_PB)};
        pg8::gemm_phase<EpiDown, DownOrder, PG8_ALIGN, PG8_SP2>(L, g, S, E);
    }
#endif
    GRID_SYNC();
#ifdef PROBE_BASE
    {
        const bf16* Y = (const bf16*)(PROBE_BASE);
        for (size_t i = (size_t)blockIdx.x * NTHREADS + tid; i < (size_t)NB * SEQ * DM + (size_t)TOKS * DM; i += (size_t)G * NTHREADS) P.out[i] = bf2f(Y[i % ((size_t)PROBE_N)]);
    }
#endif
#ifdef REP_SYNC
    for (int rep = 0; rep < REP_SYNC; ++rep) GRID_SYNC();
#endif
#ifndef NO_P8
    {
        const int lane = tid & 63, gw = blockIdx.x * 8 + (tid >> 6), NGW = G * 8;
        f32x4 gf[4];
#pragma unroll
        for (int j = 0; j < 4; ++j) gf[j] = ((const f32x4*)P.in[19])[lane + 64 * j];
        for (int orow = gw; orow < NB * SEQ + TOKS; orow += NGW) {
            f32x4* y = (f32x4*)(P.out + (size_t)orow * DM) + lane; f32x4 v[4]; float q = 0.f;
            if (orow >= NB * SEQ) {
                const int rs = orow - NB * SEQ; const f32x4* h2 = (const f32x4*)((const float*)(ws + WS_H2) + (size_t)orow * DM) + lane;
                const float* pb = (const float*)(ws + WS_PB) + (size_t)((rs >> 8) * 4) * 16 * 65536 + (size_t)(rs & 255) * 256 + 4 * lane;
#pragma unroll
                for (int j = 0; j < 4; ++j) { f32x4 a = h2[64 * j];
#pragma unroll
                    for (int sl = 0; sl < 16; ++sl) a += *(const f32x4*)(pb + (size_t)(j * 16 + sl) * 65536);
                    y[64 * j] = a; }
            }
#pragma unroll
            for (int j = 0; j < 4; ++j) { v[j] = y[64 * j]; q += (v[j].x * v[j].x + v[j].y * v[j].y) + (v[j].z * v[j].z + v[j].w * v[j].w); }
            const float rstd = 1.0f / sqrtf(wave_sum(q) * (1.f / DM) + EPS);
#pragma unroll
            for (int j = 0; j < 4; ++j) y[64 * j] = v[j] * rstd * gf[j];
        }
    }
#endif
}

extern "C" void kernel_launch(void* const* d_in, const int* in_sizes, int n_in, void* d_out, int out_size, void* d_ws, size_t ws_size, hipStream_t stream) {
    static int grid = 0;
    if (grid == 0) {
        if (n_in != 20 || (size_t)out_size != O_END || ws_size < WS_END) { fprintf(stderr, "kernel_launch: unexpected shapes: n_in %d out %d (want %zu) ws %zu (want %zu)\n", n_in, out_size, (size_t)O_END, ws_size, (size_t)WS_END); grid = -1; return; }
        int dev = 0, cus = 0, per_cu = 0;
        hipGetDevice(&dev); hipDeviceGetAttribute(&cus, hipDeviceAttributeMultiprocessorCount, dev);
        if (hipFuncSetAttribute((const void*)mk_fwd, hipFuncAttributeMaxDynamicSharedMemorySize, LDS_BYTES) != hipSuccess) { fprintf(stderr, "kernel_launch: hipFuncSetAttribute failed\n"); grid = -1; return; }
        if (hipOccupancyMaxActiveBlocksPerMultiprocessor(&per_cu, (const void*)mk_fwd, NTHREADS, LDS_BYTES) != hipSuccess || per_cu < 1) { fprintf(stderr, "kernel_launch: occupancy query says %d\n", per_cu); (void)hipGetLastError(); grid = -1; return; }
        grid = cus * (per_cu > 1 ? 1 : per_cu);
    }
    if (grid < 0) return;
    if (hipMemsetAsync((char*)d_ws + WS_CTL, 0, 65536, stream) != hipSuccess) { fprintf(stderr, "kernel_launch: hipMemsetAsync failed\n"); return; }
    Params p{};
    for (int i = 0; i < 20; ++i) p.in[i] = (const float*)d_in[i];
    p.out = (float*)d_out; p.ws = (unsigned char*)d_ws;
    void* args[] = {&p};
    hipError_t e = hipLaunchCooperativeKernel((const void*)mk_fwd, dim3(grid), dim3(NTHREADS), args, LDS_BYTES, stream);
    if (e != hipSuccess) fprintf(stderr, "kernel_launch: cooperative launch failed: %s (grid %d)\n", hipGetErrorString(e), grid);
}
```
